# Optimizing an MI355X kernel written in HIP

```python
import math
import jax
import jax.numpy as jnp
from jax import lax
import numpy as np

D_MODEL = 1024
BATCH = 8
SEQ = 2048
DEPTH = 1
DEC_BATCH = 128
DEC_SEQ = 8
PAST_LEN = 16384
PAGE_SIZE = 128

N_HEADS_A = 4
HEAD_K = 128
HEAD_V = 128
QK_W = N_HEADS_A * HEAD_K
WIDTH_A = N_HEADS_A * HEAD_V
QKV_W = 2 * QK_W + WIDTH_A
CONV_W = 4
CHUNK = 64
POOL_WINDOWS = (2, 4, 8, 16)
N_POOL_GROUPS = 4
POOL_GROUP = 128
WIDTH_B = N_POOL_GROUPS * POOL_GROUP
POOL_HIST = 15
D_FF = 4 * D_MODEL
EPS = 1e-6
IN_SPLITS = (QK_W, QK_W, WIDTH_A, WIDTH_A, N_HEADS_A, N_HEADS_A, WIDTH_B, D_MODEL, D_MODEL)
IN_W = 2 * QK_W + 2 * WIDTH_A + 2 * N_HEADS_A + WIDTH_B + 2 * D_MODEL

kernel_name = 'hybrid_gdn_pool_decoder_step'


def rmsnorm(x, g):
    xf = x.astype(jnp.float32)
    return xf * lax.rsqrt(jnp.mean(xf * xf, axis=-1, keepdims=True) + EPS) * g.astype(jnp.float32)


def l2norm(x):
    return x * lax.rsqrt(jnp.sum(x * x, axis=-1, keepdims=True) + EPS)


def gated_delta_rule(q, k, v, g, beta, s0):
    b, h, l, dk = q.shape
    dv = v.shape[-1]
    c = CHUNK if l % CHUNK == 0 else l
    n = l // c
    rs = lambda t: t.reshape((b, h, n, c) + t.shape[3:])
    q, k, v, g, beta = rs(q), rs(k), rs(v), rs(g), rs(beta)
    g = jnp.cumsum(g, axis=-1)
    idx = jnp.arange(c)
    causal = idx[:, None] >= idx[None, :]
    strict = idx[:, None] > idx[None, :]
    decay = jnp.exp(jnp.where(causal, g[..., :, None] - g[..., None, :], -jnp.inf))
    kk = jnp.einsum('bhnid,bhnjd->bhnij', k, k)
    m = jnp.where(strict, kk * decay * beta[..., :, None], 0.0)
    a = m + jnp.eye(c, dtype=jnp.float32)
    eg = jnp.exp(g)
    rhs = jnp.concatenate([v * beta[..., None], k * (beta * eg)[..., None]], axis=-1)
    sol = lax.linalg.triangular_solve(a, rhs, left_side=True, lower=True, unit_diagonal=True)
    u, w = sol[..., :dv], sol[..., dv:]
    qk = jnp.where(causal, jnp.einsum('bhnid,bhnjd->bhnij', q, k) * decay, 0.0)
    q_dec = q * eg[..., None]
    k_dec = k * jnp.exp(g[..., -1:] - g)[..., None]
    last = jnp.exp(g[..., -1])

    def step(s, inp):
        u_c, w_c, qk_c, qd_c, kd_c, last_c = inp
        v_new = u_c - jnp.einsum('bhcd,bhde->bhce', w_c, s)
        o = jnp.einsum('bhcd,bhde->bhce', qd_c, s) + jnp.einsum('bhij,bhje->bhie', qk_c, v_new)
        s = s * last_c[..., None, None] + jnp.einsum('bhcd,bhce->bhde', kd_c, v_new)
        return s, o

    xs = (jnp.moveaxis(u, 2, 0), jnp.moveaxis(w, 2, 0), jnp.moveaxis(qk, 2, 0),
          jnp.moveaxis(q_dec, 2, 0), jnp.moveaxis(k_dec, 2, 0), jnp.moveaxis(last, 2, 0))
    s, o = lax.scan(step, s0, xs)
    o = jnp.moveaxis(o, 0, 2).reshape(b, h, l, dv)
    return o, s


def gated_delta_branch(q, k, v, z, b_raw, a_raw, conv_prev, s0, w_conv, a_log, dt_bias, w_onorm):
    bsz, l, _ = q.shape
    qkv = jnp.concatenate([q, k, v], axis=-1)
    full = jnp.concatenate([conv_prev.astype(jnp.float32), qkv], axis=1)
    conv = lax.conv_general_dilated(full, w_conv.astype(jnp.float32)[:, None, :], (1,), 'VALID',
                                    dimension_numbers=('NWC', 'WIO', 'NWC'),
                                    feature_group_count=QKV_W)
    conv = jax.nn.silu(conv)
    qc, kc, vc = conv[..., :QK_W], conv[..., QK_W:2 * QK_W], conv[..., 2 * QK_W:]
    qh = jnp.swapaxes(l2norm(qc.reshape(bsz, l, N_HEADS_A, HEAD_K)) * (HEAD_K ** -0.5), 1, 2)
    kh = jnp.swapaxes(l2norm(kc.reshape(bsz, l, N_HEADS_A, HEAD_K)), 1, 2)
    vh = jnp.swapaxes(vc.reshape(bsz, l, N_HEADS_A, HEAD_V), 1, 2)
    beta = jnp.swapaxes(jax.nn.sigmoid(b_raw), 1, 2)
    g = jnp.swapaxes(-jnp.exp(a_log.astype(jnp.float32)) * jax.nn.softplus(a_raw + dt_bias), 1, 2)
    o, s = gated_delta_rule(qh, kh, vh, g, beta, s0.astype(jnp.float32))
    o = jnp.swapaxes(o, 1, 2)
    o = rmsnorm(o, w_onorm) * jax.nn.silu(z.reshape(bsz, l, N_HEADS_A, HEAD_V))
    return o.reshape(bsz, l, WIDTH_A), full[:, -(CONV_W - 1):], s


def pool_branch(p, pool_prev, pos0, w_mix, scale):
    bsz, l, _ = p.shape
    full = jnp.concatenate([pool_prev.astype(jnp.float32), p], axis=1)
    c0 = jnp.concatenate([jnp.zeros((bsz, 1, WIDTH_B), jnp.float32), jnp.cumsum(full, axis=1)], axis=1)
    end = c0[:, POOL_HIST + 1:]
    pos = pos0 + jnp.arange(l)
    outs = []
    for gi, win in enumerate(POOL_WINDOWS):
        lo, hi = gi * POOL_GROUP, (gi + 1) * POOL_GROUP
        start = c0[:, POOL_HIST + 1 - win:POOL_HIST + 1 - win + l, lo:hi]
        cnt = jnp.minimum(pos + 1, win).astype(jnp.float32)
        outs.append((end[..., lo:hi] - start) / cnt[None, :, None])
    pooled = jnp.concatenate(outs, axis=-1) - p
    mixed = jnp.einsum('blgc,gcd->blgd', pooled.reshape(bsz, l, N_POOL_GROUPS, POOL_GROUP), w_mix)
    return mixed.reshape(bsz, l, WIDTH_B) * scale, full[:, -POOL_HIST:]


def trunk(x, conv_prev, pool_prev, ssm_prev, pos0, w_in, w_conv, a_log, dt_bias, w_onorm,
          w_pool_mix, pool_scale, w_a_out, w_b_out, w_o, g_attn, g_mlp, w_up, w_down, g_final):
    out_dtype = x.dtype
    x = x.astype(jnp.float32)
    offs = np.cumsum(IN_SPLITS)[:-1].tolist()
    convs, pools, ssms = [], [], []
    for i in range(DEPTH):
        h = rmsnorm(x, g_attn[i])
        q, k, v, z, b_raw, a_raw, p, ga, gb = jnp.split(h @ w_in[i], offs, axis=-1)
        o_a, conv_new, s_new = gated_delta_branch(q, k, v, z, b_raw, a_raw, conv_prev[i], ssm_prev[i],
                                                  w_conv[i], a_log[i], dt_bias[i], w_onorm[i])
        o_b, pool_new = pool_branch(p, pool_prev[i], pos0, w_pool_mix[i], pool_scale[i])
        merged = jax.nn.sigmoid(ga) * (o_a @ w_a_out[i]) + jax.nn.sigmoid(gb) * (o_b @ w_b_out[i])
        x = x + merged @ w_o[i]
        h2 = rmsnorm(x, g_mlp[i])
        x = x + jnp.square(jax.nn.relu(h2 @ w_up[i])) @ w_down[i]
        convs.append(conv_new)
        pools.append(pool_new)
        ssms.append(s_new)
    y = rmsnorm(x, g_final).astype(out_dtype)
    return y, jnp.stack(convs), jnp.stack(pools), jnp.stack(ssms)


def setup_inputs(seed: int = 0) -> dict:
    key = jax.random.key(seed)
    ks = jax.random.split(key, 24)
    f32 = jnp.float32

    def nrm(k, shape, scale):
        return jax.random.normal(k, shape, f32) * scale

    dt = jnp.exp(jax.random.uniform(ks[8], (DEPTH, N_HEADS_A), f32, math.log(1e-3), math.log(1e-1)))
    return {
        'x_prompt': nrm(ks[0], (BATCH, SEQ, D_MODEL), 1.0),
        'x_sample': nrm(ks[1], (DEC_BATCH, DEC_SEQ, D_MODEL), 1.0),
        'state_conv': nrm(ks[2], (DEPTH, DEC_BATCH, CONV_W - 1, QKV_W), 1.0),
        'state_pool': nrm(ks[3], (DEPTH, DEC_BATCH, POOL_HIST, WIDTH_B), 1.0),
        'state_ssm': nrm(ks[4], (DEPTH, DEC_BATCH, N_HEADS_A, HEAD_K, HEAD_V), 0.5),
        'w_in': nrm(ks[5], (DEPTH, D_MODEL, IN_W), D_MODEL ** -0.5),
        'w_conv': nrm(ks[6], (DEPTH, CONV_W, QKV_W), CONV_W ** -0.5),
        'a_log': jnp.log(jax.random.uniform(ks[7], (DEPTH, N_HEADS_A), f32, 1.0, 16.0)),
        'dt_bias': dt + jnp.log(-jnp.expm1(-dt)),
        'w_onorm': 1.0 + nrm(ks[9], (DEPTH, HEAD_V), 0.02),
        'w_pool_mix': nrm(ks[10], (DEPTH, N_POOL_GROUPS, POOL_GROUP, POOL_GROUP), POOL_GROUP ** -0.5),
        'pool_scale': 1.0 + nrm(ks[11], (DEPTH, WIDTH_B), 0.02),
        'w_a_out': nrm(ks[12], (DEPTH, WIDTH_A, D_MODEL), WIDTH_A ** -0.5),
        'w_b_out': nrm(ks[13], (DEPTH, WIDTH_B, D_MODEL), WIDTH_B ** -0.5),
        'w_o': nrm(ks[14], (DEPTH, D_MODEL, D_MODEL), D_MODEL ** -0.5),
        'g_attn': 1.0 + nrm(ks[15], (DEPTH, D_MODEL), 0.02),
        'g_mlp': 1.0 + nrm(ks[16], (DEPTH, D_MODEL), 0.02),
        'w_up': nrm(ks[17], (DEPTH, D_MODEL, D_FF), D_MODEL ** -0.5),
        'w_down': nrm(ks[18], (DEPTH, D_FF, D_MODEL), D_FF ** -0.5),
        'g_final': 1.0 + nrm(ks[19], (D_MODEL,), 0.02),
    }


def reference(x_prompt, x_sample, state_conv, state_pool, state_ssm, w_in, w_conv, a_log, dt_bias,
              w_onorm, w_pool_mix, pool_scale, w_a_out, w_b_out, w_o, g_attn, g_mlp, w_up, w_down,
              g_final):
    bp = x_prompt.shape[0]
    zero_conv = jnp.zeros((DEPTH, bp, CONV_W - 1, QKV_W), jnp.float32)
    zero_pool = jnp.zeros((DEPTH, bp, POOL_HIST, WIDTH_B), jnp.float32)
    zero_ssm = jnp.zeros((DEPTH, bp, N_HEADS_A, HEAD_K, HEAD_V), jnp.float32)
    y_prompt, conv_p, pool_p, ssm_p = trunk(
        x_prompt, zero_conv, zero_pool, zero_ssm, 0, w_in, w_conv, a_log, dt_bias, w_onorm,
        w_pool_mix, pool_scale, w_a_out, w_b_out, w_o, g_attn, g_mlp, w_up, w_down, g_final)
    y_sample, conv_s, pool_s, ssm_s = trunk(
        x_sample, state_conv, state_pool, state_ssm, PAST_LEN, w_in, w_conv, a_log, dt_bias, w_onorm,
        w_pool_mix, pool_scale, w_a_out, w_b_out, w_o, g_attn, g_mlp, w_up, w_down, g_final)
    return (y_prompt, y_sample,
            conv_p.astype(state_conv.dtype), pool_p.astype(state_pool.dtype), ssm_p.astype(state_ssm.dtype),
            conv_s.astype(state_conv.dtype), pool_s.astype(state_pool.dtype), ssm_s.astype(state_ssm.dtype))
```

```cpp
#include <hip/hip_runtime.h>
#include <hip/hip_cooperative_groups.h>
#include <cstdio>
#include <cstdint>
namespace cg = cooperative_groups;

typedef unsigned short bf16_t;
typedef short bf16x8 __attribute__((ext_vector_type(8)));
typedef float f32x4 __attribute__((ext_vector_type(4)));
typedef unsigned u32x4 __attribute__((ext_vector_type(4)));
typedef unsigned u32x2 __attribute__((ext_vector_type(2)));

constexpr int T_ALL = 17408, T_P = 16384, DM = 1024, NIN = 4608, DFF = 4096, INW = 4616;
constexpr int NTHR = 512;
constexpr int LDS_BYTES = 131072 + 256;
constexpr float EPS = 1e-6f;

constexpr size_t OFF_WT1 = 0;
constexpr size_t OFF_WAT = 9437184;
constexpr size_t OFF_WBT = 10485760;
constexpr size_t OFF_WOT = 11534336;
constexpr size_t OFF_WUT = 13631488;
constexpr size_t OFF_WDT = 22020096;
constexpr size_t OFF_RSTD1 = 30408704;
constexpr size_t OFF_BETA = 30478336;
constexpr size_t OFF_GL = 30756864;
constexpr size_t OFF_SSQ2 = 252198912;
constexpr size_t OFF_SSQ3 = 253313024;
constexpr size_t OFF_R1 = 33554432;
constexpr size_t OFF_WC = OFF_R1;
constexpr size_t OFF_PL = OFF_R1 + 16777216;
constexpr size_t OFF_QKV = 69206016;
constexpr size_t OFF_ZB = 122683392;
constexpr size_t OFF_PB = 140509184;
constexpr size_t OFF_U = 158334976;
constexpr size_t OFF_QN = 191889408;
constexpr size_t OFF_KT = 208666624;
constexpr size_t OFF_QK = 225443840;
constexpr size_t OFF_SC = 233832448;
constexpr size_t OFF_OA = 234373120;
constexpr size_t OFF_ORAW = OFF_QKV;
constexpr size_t OFF_HMID = OFF_QKV;
constexpr size_t OFF_PART = OFF_QKV + 142606336;
constexpr size_t OFF_BAR = 254427136;
constexpr size_t OFF_SSQP = 254427136 + 16384;
constexpr size_t OFF_SFIN = OFF_SSQP + 2097152;
constexpr size_t WS_END = OFF_SFIN + 2097152;

constexpr size_t O_Y = 0;
constexpr size_t O_CONVP = 17825792;
constexpr size_t O_POOLP = 17862656;
constexpr size_t O_SSMP = 17924096;
constexpr size_t O_CONVS = 18448384;
constexpr size_t O_POOLS = 19038208;
constexpr size_t O_SSMS = 20021248;

struct Params {
    const float* in[20];
    float* out;
    unsigned char* ws;
};

typedef __bf16 bf16x2_t_ __attribute__((ext_vector_type(2)));
typedef float f32x2_t_ __attribute__((ext_vector_type(2)));
__device__ __forceinline__ unsigned cvt_pk_bf16(float lo, float hi) { f32x2_t_ v = {lo, hi}; bf16x2_t_ b = __builtin_convertvector(v, bf16x2_t_); return __builtin_bit_cast(unsigned, b); }
__device__ __forceinline__ unsigned pk_bf16_c(float lo, float hi) { return cvt_pk_bf16(lo, hi); }
__device__ __forceinline__ bf16_t f2bf(float f) { return (bf16_t)(cvt_pk_bf16(f, 0.f) & 0xffffu); }
__device__ __forceinline__ float bf2f(bf16_t b) { return __uint_as_float(((unsigned)b) << 16); }
__device__ __forceinline__ float bflo(unsigned u) { return __uint_as_float(u << 16); }
__device__ __forceinline__ float bfhi(unsigned u) { return __uint_as_float(u & 0xffff0000u); }
__device__ __forceinline__ bf16x8 mk8(unsigned a, unsigned b, unsigned c, unsigned d) { u32x4 u = {a, b, c, d}; return __builtin_bit_cast(bf16x8, u); }
__device__ __forceinline__ float sigmoidf_(float x) { return __builtin_amdgcn_rcpf(1.0f + __expf(-x)); }
__device__ __forceinline__ float siluf_(float x) { return x * __builtin_amdgcn_rcpf(1.0f + __expf(-x)); }

#define LAS __attribute__((address_space(3)))
constexpr int BM = 256, BK = 64, HALF = 128, HTB = HALF * BK * 2;
__device__ __forceinline__ int lds_byte(int r, int c) { const int st = (r >> 4) * 2 + (c >> 5), rr = r & 15, cc = c & 31, ob = rr * 64 + cc * 2; return st * 1024 + (ob ^ (((ob >> 9) & 1) << 5)); }
__device__ __forceinline__ void stage_rc(int b, int& R, int& C) { const int st = b / 1024, sb = b % 1024, swz = sb ^ (((sb >> 9) & 1) << 5); R = (st >> 1) * 16 + swz / 64; C = (st & 1) * 32 + (swz % 64) / 2; }

__device__ __forceinline__ void unit_of(int L, int nM, int nN, int& pm, int& pn) {
    const int nwg = nM * nN; int wgid = L;
    { const int q = nwg / 8, r = nwg % 8, xcd = wgid % 8, off = wgid / 8; wgid = (xcd < r ? xcd * (q + 1) : r * (q + 1) + (xcd - r) * q) + off; }
    const int nig = 8 * nN, gid = wgid / nig, fm = gid * 8, gsz = (nM - fm) < 8 ? (nM - fm) : 8;
    pm = fm + ((wgid % nig) % gsz); pn = (wgid % nig) / gsz;
}

struct SchedStatic {
    int nM, nN, nt, G, cb;
    __device__ __forceinline__ bool get(int i, int& pm, int& pn, int& k0, int& ntu, int& set) const {
        const int L = i * G + cb; if (L >= nM * nN) return false;
        unit_of(L, nM, nN, pm, pn); k0 = 0; ntu = nt; set = 0; return true; }
};
struct SchedTwoPass {
    int nM, nN, nt, G, cb;
    __device__ __forceinline__ bool get(int i, int& pm, int& pn, int& k0, int& ntu, int& set) const {
        const int L = (i >> 1) * G + cb; if (L >= nM * nN) return false;
        unit_of(L, nM, nN, pm, pn); k0 = 0; ntu = nt; set = i & 1; return true; }
};
struct SchedStreamK {
    int pn_, ntK, per, w;
    __device__ __forceinline__ bool get(int i, int& pm, int& pn, int& k0, int& ntu, int& set) const {
        set = 0;
        if (i > 1) return false;
        const int start = w * per, p0 = start / ntK, kk = start % ntK; const int len0 = (ntK - kk) < per ? (ntK - kk) : per;
        if (i == 0) { pm = p0; k0 = kk; ntu = len0; } else { if (len0 >= per) return false; pm = p0 + 1; k0 = 0; ntu = per - len0; }
        pn = pn_; return true; }
};

template <class Epi, class Sched>
__device__ __forceinline__ void gemm_phase(const bf16_t* __restrict__ A, const bf16_t* __restrict__ Bt, const int K, const Sched& SD, const Epi& E, const bf16_t* __restrict__ A2 = nullptr, const bf16_t* __restrict__ Bt2 = nullptr) {
    extern __shared__ __attribute__((aligned(16))) unsigned char smem[];
    LAS unsigned char* lds = (LAS unsigned char*)smem;
    int tid = threadIdx.x; asm volatile("" : "+v"(tid));
    const int wid = __builtin_amdgcn_readfirstlane(tid >> 6), lane = tid & 63, wr = wid >> 2, wc = wid & 3, fr = lane & 15, fq = lane >> 4;
    unsigned voff[2], voffB[2];
#pragma unroll
    for (int i = 0; i < 2; ++i) { int R, C; stage_rc(tid * 16 + i * 8192, R, C); voff[i] = (unsigned)(R * K + C) * 2u;
        const int rho = R & 31; const int Rb = (R & ~31) + 8 * ((rho & 15) >> 2) + 4 * (rho >> 4) + (rho & 3); voffB[i] = (unsigned)(Rb * K + C) * 2u; }
    const size_t kstep = (size_t)(BK * 2);
    const size_t hstep = (size_t)HALF * K * 2;
    const size_t tstep = 2 * hstep;
    const unsigned ldsw = (unsigned)wid * 1024u;
    const int aoff = lds_byte(wr * 64 + fr, fq * 8), boff = lds_byte(wc * 32 + fr, fq * 8);
#define G_SA(b, h) (((b) * 2 + (h)) * HTB)
#define G_SB(b, h) ((4 + (b) * 2 + (h)) * HTB)
#define G_STAGE_(bufoff, gbase, vo) do { _Pragma("unroll") for (int _i = 0; _i < 2; ++_i) \
        __builtin_amdgcn_global_load_lds((const unsigned*)((const char*)(gbase) + vo[_i]), (LAS unsigned*)(lds + (bufoff) + ldsw + _i * 8192), 16, 0, 0); } while (0)
#define G_STAGE(bufoff, gbase) G_STAGE_(bufoff, gbase, voff)
#define G_STAGEB(bufoff, gbase) G_STAGE_(bufoff, gbase, voffB)
#define G_LDA(dst, b, h) do { _Pragma("unroll") for (int m = 0; m < 4; ++m) _Pragma("unroll") for (int k = 0; k < 2; ++k) dst[m][k] = *(const LAS bf16x8*)(lds + G_SA(b, h) + aoff + m * 2048 + k * 1024); } while (0)
#define G_LDB(dst, b, h) do { _Pragma("unroll") for (int n = 0; n < 2; ++n) _Pragma("unroll") for (int k = 0; k < 2; ++k) dst[n][k] = *(const LAS bf16x8*)(lds + G_SB(b, h) + boff + n * 2048 + k * 1024); } while (0)
#define G_MMA(ai, bj, Af, Bf) do { __builtin_amdgcn_s_setprio(1); _Pragma("unroll") for (int m = 0; m < 4; ++m) _Pragma("unroll") for (int n = 0; n < 2; ++n) _Pragma("unroll") for (int k = 0; k < 2; ++k) \
        acc[ai][bj][m][n] = __builtin_amdgcn_mfma_f32_16x16x32_bf16(Bf[n][k], Af[m][k], acc[ai][bj][m][n], 0, 0, 0); __builtin_amdgcn_s_setprio(0); } while (0)
#define G_WAIT_V(n) asm volatile("s_waitcnt vmcnt(" #n ")" ::: "memory")
#define G_WAIT_L(n) asm volatile("s_waitcnt lgkmcnt(" #n ")" ::: "memory")
#define G_BAR __builtin_amdgcn_s_barrier()
#define G_SCHED __builtin_amdgcn_sched_barrier(0)
    int ui = 0, pm, pn, k0, nt, set, npm = 0, npn = 0, nk0 = 0, nnt = 0, nset = 0;
    if (!SD.get(0, pm, pn, k0, nt, set)) return;
    f32x4 acc[2][2][4][2];
#pragma unroll
    for (int a = 0; a < 2; ++a)
#pragma unroll
        for (int b = 0; b < 2; ++b)
#pragma unroll
            for (int m = 0; m < 4; ++m)
#pragma unroll
                for (int n = 0; n < 2; ++n) acc[a][b][m][n] = (f32x4){0.f, 0.f, 0.f, 0.f};
    bf16x8 At[4][2], B0[2][2], B1[2][2];
    const char* cA = (const char*)(set ? A2 : A) + (size_t)pm * tstep + (size_t)k0 * kstep; const char* cB = (const char*)(set ? Bt2 : Bt) + (size_t)pn * tstep + (size_t)k0 * kstep;
    G_STAGEB(G_SB(0, 0), cB); G_STAGEB(G_SB(0, 1), cB + hstep); G_STAGE(G_SA(0, 0), cA); G_STAGE(G_SA(0, 1), cA + hstep);
    if (wr == 1) G_BAR;
    G_WAIT_V(2); G_BAR;
    G_STAGEB(G_SB(1, 0), cB + kstep); G_STAGE(G_SA(1, 0), cA + kstep); G_STAGEB(G_SB(1, 1), cB + hstep + kstep);
    G_WAIT_V(6); G_BAR;
    for (;;) {
        const bool has_next = SD.get(ui + 1, npm, npn, nk0, nnt, nset);
        const char* nA = has_next ? (const char*)(nset ? A2 : A) + (size_t)npm * tstep + (size_t)nk0 * kstep : cA; const char* nB = has_next ? (const char*)(nset ? Bt2 : Bt) + (size_t)npn * tstep + (size_t)nk0 * kstep : cB;
#pragma unroll 1
        for (int t = 0; t < nt; t += 2) {
            const bool last = (t == nt - 2);
            const char* a1 = cA + (size_t)(t + 1) * kstep;
            const char* a2 = last ? nA : cA + (size_t)(t + 2) * kstep; const char* b2 = last ? nB : cB + (size_t)(t + 2) * kstep;
            const char* a3 = a2 + kstep; const char* b3 = b2 + kstep;
            G_LDB(B0, 0, 0); G_LDB(B1, 0, 1); G_SCHED; G_LDA(At, 0, 0); G_STAGE(G_SA(1, 1), a1 + hstep);
            G_WAIT_V(8); G_WAIT_L(0); G_BAR; G_MMA(0, 0, At, B0); G_MMA(0, 1, At, B1); G_BAR; G_SCHED;
            G_LDA(At, 0, 1); G_STAGEB(G_SB(0, 0), b2); G_STAGEB(G_SB(0, 1), b2 + hstep); G_STAGE(G_SA(0, 0), a2);
            G_WAIT_V(8); G_WAIT_L(0); G_BAR; G_MMA(1, 0, At, B0); G_MMA(1, 1, At, B1); G_BAR; G_SCHED;
            G_LDB(B0, 1, 0); G_LDB(B1, 1, 1); G_SCHED; G_LDA(At, 1, 0); G_STAGE(G_SA(0, 1), a2 + hstep);
            G_WAIT_V(8); G_WAIT_L(0); G_BAR; G_MMA(0, 0, At, B0); G_MMA(0, 1, At, B1); G_BAR; G_SCHED;
            G_LDA(At, 1, 1); G_STAGEB(G_SB(1, 0), b3); G_STAGEB(G_SB(1, 1), b3 + hstep); G_STAGE(G_SA(1, 0), a3);
            G_WAIT_V(8); G_WAIT_L(0); G_BAR; G_MMA(1, 0, At, B0); G_MMA(1, 1, At, B1); G_BAR; G_SCHED;
        }
        if (wr == 0) G_BAR;
        const bool keep = E(acc, pm, pn, wr, wc, fr, fq, ui);
        if (!has_next) break;
        if (!keep)
#pragma unroll
        for (int a = 0; a < 2; ++a)
#pragma unroll
            for (int b = 0; b < 2; ++b)
#pragma unroll
                for (int m = 0; m < 4; ++m)
#pragma unroll
                    for (int n = 0; n < 2; ++n) acc[a][b][m][n] = (f32x4){0.f, 0.f, 0.f, 0.f};
        pm = npm; pn = npn; nt = nnt; cA = nA; cB = nB; ++ui;
        if (wr == 1) G_BAR;
    }
    G_WAIT_V(0);
    G_BAR;
#undef G_SA
#undef G_SB
#undef G_STAGE
#undef G_STAGEB
#undef G_STAGE_
#undef G_LDA
#undef G_LDB
#undef G_MMA
}
typedef f32x4 acc_t[2][2][4][2];
#define EPI_ROWS(body) _Pragma("unroll") for (int ai = 0; ai < 2; ++ai) _Pragma("unroll") for (int m = 0; m < 4; ++m) { const int row = pm * 256 + ai * 128 + wr * 64 + m * 16 + fr; body }
#define EPI_COLS8(body) _Pragma("unroll") for (int bj = 0; bj < 2; ++bj) { const int col = pn * 256 + bj * 128 + wc * 32 + fq * 8; const f32x4 a0 = acc[ai][bj][m][0]; const f32x4 a1 = acc[ai][bj][m][1]; body }
__device__ __forceinline__ u32x4 pack8(const f32x4& v0, const f32x4& v1) { u32x4 w; w.x = cvt_pk_bf16(v0[0], v0[1]); w.y = cvt_pk_bf16(v0[2], v0[3]); w.z = cvt_pk_bf16(v1[0], v1[1]); w.w = cvt_pk_bf16(v1[2], v1[3]); return w; }

#define XB_TMO      128
#define XB_XCNT(j)  (256  + 64 * (j))
#define XB_XSUB(j)  (1280 + 64 * (j))
#define XB_XGEN(j)  (2304 + 64 * (j))
#define XB_TOP      3328
#define XB_TOPGEN   3392
#define XCD_BAR_WORDS 3456
#define XB_SPIN_CAP (1u << 20)
__device__ __forceinline__ unsigned xb_ld(unsigned* p)              { return __hip_atomic_load(p, __ATOMIC_RELAXED, __HIP_MEMORY_SCOPE_AGENT); }
__device__ __forceinline__ unsigned xb_add(unsigned* p, unsigned v) { return __hip_atomic_fetch_add(p, v, __ATOMIC_RELAXED, __HIP_MEMORY_SCOPE_AGENT); }
__device__ __forceinline__ unsigned xb_xcc_id() { return (unsigned)__builtin_amdgcn_s_getreg((3 << 11) | 20) & 0xFu; }
#define XB_SPIN(cond, bar) do { unsigned _sp = 0; while (cond) { __builtin_amdgcn_s_sleep(1); \
    if ((++_sp & 255u) == 0u) { if (xb_ld(&(bar)[XB_TMO])) break; if (_sp > XB_SPIN_CAP) { atomicAdd(&(bar)[XB_TMO], 1u); break; } } } } while (0)
struct XcdBarrier { unsigned* bar; unsigned x; volatile LAS unsigned* st; };
__device__ __forceinline__ XcdBarrier xcd_barrier_post(unsigned* bar, volatile LAS unsigned* st) {
    XcdBarrier b; b.bar = bar; b.x = xb_xcc_id(); b.st = st;
    if (threadIdx.x == 0) (void)xb_add(&bar[XB_XCNT(b.x)], 1u);
    return b;
}
__device__ __forceinline__ void xcd_barrier_complete(unsigned* bar, unsigned x, unsigned& nloc, unsigned& nx) {
    const unsigned G = gridDim.x * gridDim.y * gridDim.z;
    unsigned sum, cnt, mine, sp = 0u;
    for (;;) {
        sum = 0u; cnt = 0u; mine = 0u;
#pragma unroll
        for (unsigned j = 0; j < 16; ++j) { const unsigned c = xb_ld(&bar[XB_XCNT(j)]); sum += c; cnt += (c > 0u) ? 1u : 0u; mine = (j == x) ? c : mine; }
        if (sum == G) break;
        __builtin_amdgcn_s_sleep(1);
        if ((++sp & 255u) == 0u) { if (xb_ld(&bar[XB_TMO])) break; if (sp > XB_SPIN_CAP) { atomicAdd(&bar[XB_TMO], 1u); break; } }
    }
    nloc = mine > 0u ? mine : 1u; nx = cnt > 0u ? cnt : 1u;
}
__device__ __forceinline__ void xcd_barrier(const XcdBarrier& b) {
    asm volatile("s_waitcnt vmcnt(0)" ::: "memory");
    __syncthreads();
    if (threadIdx.x == 0) {
        unsigned* bar = b.bar;
        __builtin_amdgcn_s_waitcnt(0);
        unsigned nloc = b.st[0], nx = b.st[1];
        if (nloc == 0u) { xcd_barrier_complete(bar, b.x, nloc, nx); b.st[0] = nloc; b.st[1] = nx; }
        const unsigned old = xb_add(&bar[XB_XSUB(b.x)], 1u);
        const unsigned gen = old / nloc;
        if (old + 1u == (gen + 1u) * nloc) {
            __builtin_amdgcn_fence(__ATOMIC_RELEASE, "agent");
            asm volatile("s_waitcnt vmcnt(0)" ::: "memory");
            const unsigned og = xb_add(&bar[XB_TOP], 1u);
            const unsigned tg = og / nx;
            if (og + 1u == (tg + 1u) * nx) xb_add(&bar[XB_TOPGEN], 1u);
            else XB_SPIN(xb_ld(&bar[XB_TOPGEN]) == tg, bar);
            __builtin_amdgcn_fence(__ATOMIC_ACQUIRE, "agent");
            xb_add(&bar[XB_XGEN(b.x)], 1u);
            asm volatile("s_waitcnt vmcnt(0)" ::: "memory");
        } else {
            XB_SPIN(xb_ld(&bar[XB_XGEN(b.x)]) == gen, bar);
            __builtin_amdgcn_fence(__ATOMIC_ACQUIRE, "agent");
            asm volatile("s_waitcnt vmcnt(0)" ::: "memory");
        }
    }
    __syncthreads();
}

__device__ void p0_transpose_tile(const float* __restrict__ src, int ldn, int K, const float* __restrict__ g, bool in_map, bf16_t* __restrict__ dst, int k0, int n0) {
    extern __shared__ __attribute__((aligned(16))) unsigned char smem[];
    float* tl = (float*)smem;
    const int tid = threadIdx.x;
    f32x4 v[8];
#pragma unroll
    for (int i = 0; i < 8; ++i) { const int idx = tid + i * NTHR; const int r = idx >> 6, c4 = (idx & 63) * 4;
        const int n = n0 + c4; const int sc = in_map ? (n < 2048 ? n : n + 8) : n;
        v[i] = __builtin_nontemporal_load((const f32x4*)(src + (size_t)(k0 + r) * ldn + sc)); }
    __syncthreads();
#pragma unroll
    for (int i = 0; i < 8; ++i) { const int idx = tid + i * NTHR; const int r = idx >> 6, c4 = (idx & 63) * 4;
        const float gs = g ? g[k0 + r] : 1.0f;
        tl[r * 257 + c4 + 0] = v[i][0] * gs; tl[r * 257 + c4 + 1] = v[i][1] * gs; tl[r * 257 + c4 + 2] = v[i][2] * gs; tl[r * 257 + c4 + 3] = v[i][3] * gs; }
    __syncthreads();
    { const int kp = (tid & 7) * 8;
#pragma unroll
      for (int ps = 0; ps < 4; ++ps) { const int n = ps * 64 + (tid >> 3); float x[8];
#pragma unroll
          for (int i = 0; i < 8; ++i) x[i] = tl[(kp + i) * 257 + n];
          u32x4 w; w.x = cvt_pk_bf16(x[0], x[1]); w.y = cvt_pk_bf16(x[2], x[3]); w.z = cvt_pk_bf16(x[4], x[5]); w.w = cvt_pk_bf16(x[6], x[7]);
          *(u32x4*)(dst + (size_t)(n0 + n) * K + k0 + kp) = w; } }
}

__device__ void p0_fold_tile(const Params& p, int ct, int ntile) {
    extern __shared__ __attribute__((aligned(16))) unsigned char smem[];
    float* Am = (float*)smem;
    float* Bm = Am + 64 * 129;
    const int tid = threadIdx.x;
    const float* wmix = p.in[10]; const float* pscale = p.in[11]; const float* wb = p.in[13];
    bf16_t* WBT = (bf16_t*)(p.ws + OFF_WBT);
    const int c0 = ct * 64, gi = c0 >> 7, cl0 = c0 & 127, n0 = ntile * 64;
    __syncthreads();
    for (int idx = tid; idx < 64 * 128; idx += NTHR) { const int c = idx >> 7, d = idx & 127; Am[c * 129 + d] = wmix[((size_t)gi * 128 + cl0 + c) * 128 + d] * pscale[gi * 128 + d]; }
    for (int idx = tid; idx < 128 * 64; idx += NTHR) { const int d = idx >> 6, n = idx & 63; Bm[d * 65 + n] = wb[(size_t)(gi * 128 + d) * 1024 + n0 + n]; }
    __syncthreads();
    const int n = tid & 63, cq = tid >> 6;
    float acc[8];
#pragma unroll
    for (int i = 0; i < 8; ++i) acc[i] = 0.f;
    for (int d = 0; d < 128; ++d) { const float bv = Bm[d * 65 + n];
#pragma unroll
        for (int i = 0; i < 8; ++i) acc[i] += Am[(cq * 8 + i) * 129 + d] * bv; }
    u32x4 w; w.x = cvt_pk_bf16(acc[0], acc[1]); w.y = cvt_pk_bf16(acc[2], acc[3]); w.z = cvt_pk_bf16(acc[4], acc[5]); w.w = cvt_pk_bf16(acc[6], acc[7]);
    *(u32x4*)(WBT + (size_t)(n0 + n) * 512 + c0 + cq * 8) = w;
}

__device__ void phase0(const Params& p) {
    extern __shared__ __attribute__((aligned(16))) unsigned char smem[];
    const int tid = threadIdx.x, G = gridDim.x;
    unsigned char* ws = p.ws;
    for (int it = blockIdx.x; it < 1024; it += G) {
        if (it < 288) { p0_transpose_tile(p.in[5], INW, 1024, p.in[15], true, (bf16_t*)(ws + OFF_WT1), (it / 18) * 64, (it % 18) * 256); }
        else if (it < 320) { const int j = it - 288; p0_transpose_tile(p.in[12], 1024, 512, nullptr, false, (bf16_t*)(ws + OFF_WAT), (j / 4) * 64, (j % 4) * 256); }
        else if (it < 384) { const int j = it - 320; p0_transpose_tile(p.in[14], 1024, 1024, nullptr, false, (bf16_t*)(ws + OFF_WOT), (j / 4) * 64, (j % 4) * 256); }
        else if (it < 640) { const int j = it - 384; p0_transpose_tile(p.in[17], 4096, 1024, p.in[16], false, (bf16_t*)(ws + OFF_WUT), (j / 16) * 64, (j % 16) * 256); }
        else if (it < 896) { const int j = it - 640; p0_transpose_tile(p.in[18], 1024, 4096, nullptr, false, (bf16_t*)(ws + OFF_WDT), (j / 4) * 64, (j % 4) * 256); }
        else { const int j = it - 896; p0_fold_tile(p, j / 16, j % 16); }
    }
    __syncthreads();
    float* WBA = (float*)smem;
    { const float* win = p.in[5]; const float* ga = p.in[15];
      for (int idx = tid; idx < 8192; idx += NTHR) { const int k = idx >> 3, j = idx & 7; WBA[j * 1024 + k] = ga[k] * win[(size_t)k * INW + 2048 + j]; } }
    __syncthreads();
    const int wave = tid >> 6, lane = tid & 63;
    bf16_t* xb = (bf16_t*)(ws + OFF_R1);
    float* rstd1 = (float*)(ws + OFF_RSTD1); float* beta = (float*)(ws + OFF_BETA); float* gl = (float*)(ws + OFF_GL);
    {
        const float mynal = -__expf(p.in[7][lane & 3]), mydtb = p.in[8][lane & 3];
        int row = blockIdx.x * 8 + wave;
        f32x4 cur[4];
        if (row < T_ALL) { const float* xr = row < T_P ? p.in[0] + (size_t)row * DM : p.in[1] + (size_t)(row - T_P) * DM;
#pragma unroll
            for (int i = 0; i < 4; ++i) cur[i] = __builtin_nontemporal_load((const f32x4*)(xr + i * 256 + lane * 4)); }
        while (row < T_ALL) {
            const int nrow = row + G * 8;
            f32x4 nxt[4];
            if (nrow < T_ALL) { const float* xr = nrow < T_P ? p.in[0] + (size_t)nrow * DM : p.in[1] + (size_t)(nrow - T_P) * DM;
#pragma unroll
                for (int i = 0; i < 4; ++i) nxt[i] = __builtin_nontemporal_load((const f32x4*)(xr + i * 256 + lane * 4)); }
            float ss = 0.f; float d[8];
#pragma unroll
            for (int j = 0; j < 8; ++j) d[j] = 0.f;
#pragma unroll
            for (int i = 0; i < 4; ++i) {
                const int col = i * 256 + lane * 4;
                const f32x4 v = cur[i];
                u32x2 w; w.x = cvt_pk_bf16(v[0], v[1]); w.y = cvt_pk_bf16(v[2], v[3]);
                *(u32x2*)(xb + (size_t)row * DM + col) = w;
                ss += (v[0] * v[0] + v[1] * v[1]) + (v[2] * v[2] + v[3] * v[3]);
#pragma unroll
                for (int j = 0; j < 8; ++j) { const f32x4 w = *(const f32x4*)(WBA + j * 1024 + col);
                    d[j] += (v[0] * w[0] + v[1] * w[1]) + (v[2] * w[2] + v[3] * w[3]); }
            }
#pragma unroll
            for (int off = 1; off < 64; off <<= 1) { ss += __shfl_xor(ss, off);
#pragma unroll
                for (int j = 0; j < 8; ++j) d[j] += __shfl_xor(d[j], off); }
            {
                const float rs = rsqrtf(ss * (1.0f / 1024.0f) + EPS);
                const int j = lane & 7;
                float dj = d[0]; dj = j == 1 ? d[1] : dj; dj = j == 2 ? d[2] : dj; dj = j == 3 ? d[3] : dj; dj = j == 4 ? d[4] : dj; dj = j == 5 ? d[5] : dj; dj = j == 6 ? d[6] : dj; dj = j == 7 ? d[7] : dj;
                const float raw = dj * rs;
                const float sg = sigmoidf_(raw);
                const float xa = raw + mydtb;
                const float ex = __expf(-fabsf(xa)); const float sp = fmaxf(xa, 0.f) + (ex < 1e-4f ? ex * (1.0f - 0.5f * ex) : __logf(1.0f + ex));
                if (lane == 0) rstd1[row] = rs;
                if (lane < 4) beta[row * 4 + lane] = sg;
                else if (lane < 8) gl[row * 4 + (lane - 4)] = mynal * sp;
            }
#pragma unroll
            for (int i = 0; i < 4; ++i) cur[i] = nxt[i];
            row = nrow;
        }
    }
    { const float* sp = p.in[3]; float* po = p.out + O_POOLS;
      for (int idx = blockIdx.x * NTHR + tid; idx < 128 * 7 * 512; idx += G * NTHR) { const int c = idx & 511, r = (idx >> 9) % 7, b = idx / (7 * 512);
          po[((size_t)b * 15 + r) * 512 + c] = sp[((size_t)b * 15 + 8 + r) * 512 + c]; } }
}

struct EpiP1 {
    const float* rstd1; bf16_t* qkv; bf16_t* zb; bf16_t* pb; bf16_t* sga; bf16_t* sgb; float* out;
    __device__ __forceinline__ bool operator()(acc_t& acc, int pm, int pn, int wr, int wc, int fr, int fq, int ui) const {
        EPI_ROWS(
            const float rs = rstd1[row];
            const bool isS = row >= T_P; int b; int t;
            if (!isS) { b = row >> 11; t = row & 2047; } else { const int r2 = row - T_P; b = r2 >> 3; t = r2 & 7; }
            EPI_COLS8(
                const f32x4 v0 = a0 * rs; const f32x4 v1 = a1 * rs;
                if (pn < 6) {
                    *(u32x4*)(qkv + (size_t)row * 1536 + col) = pack8(v0, v1);
                    const int cst = isS ? t - 5 : t - 2045;
                    if (cst >= 0) { float* dst = out + (isS ? O_CONVS : O_CONVP) + ((size_t)b * 3 + cst) * 1536 + col; *(f32x4*)dst = v0; *(f32x4*)(dst + 4) = v1; }
                } else if (pn < 8) {
                    *(u32x4*)(zb + (size_t)row * 512 + (col - 1536)) = pack8(v0, v1);
                } else if (pn < 10) {
                    const int c = col - 2048;
                    *(u32x4*)(pb + (size_t)row * 512 + c) = pack8(v0, v1);
                    if (isS) { float* dst = out + O_POOLS + ((size_t)b * 15 + 7 + t) * 512 + c; *(f32x4*)dst = v0; *(f32x4*)(dst + 4) = v1; }
                    else if (t >= 2033) { float* dst = out + O_POOLP + ((size_t)b * 15 + (t - 2033)) * 512 + c; *(f32x4*)dst = v0; *(f32x4*)(dst + 4) = v1; }
                } else {
                    f32x4 s0; f32x4 s1; const float kk_ = rs * -1.4426950408889634f;
                    s0[0] = __builtin_amdgcn_rcpf(1.0f + __builtin_amdgcn_exp2f(a0[0] * kk_)); s0[1] = __builtin_amdgcn_rcpf(1.0f + __builtin_amdgcn_exp2f(a0[1] * kk_));
                    s0[2] = __builtin_amdgcn_rcpf(1.0f + __builtin_amdgcn_exp2f(a0[2] * kk_)); s0[3] = __builtin_amdgcn_rcpf(1.0f + __builtin_amdgcn_exp2f(a0[3] * kk_));
                    s1[0] = __builtin_amdgcn_rcpf(1.0f + __builtin_amdgcn_exp2f(a1[0] * kk_)); s1[1] = __builtin_amdgcn_rcpf(1.0f + __builtin_amdgcn_exp2f(a1[1] * kk_));
                    s1[2] = __builtin_amdgcn_rcpf(1.0f + __builtin_amdgcn_exp2f(a1[2] * kk_)); s1[3] = __builtin_amdgcn_rcpf(1.0f + __builtin_amdgcn_exp2f(a1[3] * kk_));
                    bf16_t* dst = pn < 14 ? sga + (size_t)row * 1024 + (col - 2560) : sgb + (size_t)row * 1024 + (col - 3584);
                    *(u32x4*)dst = pack8(s0, s1);
                }
            )
        )
        return false;
    }
};
__device__ void phase1(const Params& p) {
    unsigned char* ws = p.ws;
    bf16_t* sga = (bf16_t*)(p.out + O_Y);
    EpiP1 E{(const float*)(ws + OFF_RSTD1), (bf16_t*)(ws + OFF_QKV), (bf16_t*)(ws + OFF_ZB), (bf16_t*)(ws + OFF_PB), sga, sga + (size_t)T_ALL * 1024, p.out};
    SchedStatic SD{T_ALL / 256, NIN / 256, 1024 / 64, (int)gridDim.x, (int)blockIdx.x};
    gemm_phase<EpiP1, SchedStatic>((const bf16_t*)(ws + OFF_R1), (const bf16_t*)(ws + OFF_WT1), 1024, SD, E);
}

__device__ __forceinline__ int fragoff(int r, int c, int nk) { return (((r >> 4) * nk + (c >> 5)) * 64 + ((c & 31) >> 3) * 16 + (r & 15)) * 8 + (c & 7); }
__device__ __forceinline__ void prep_load_raw(const Params& p, int item, bf16_t (&r)[67]) {
    const int tid = threadIdx.x;
    if (tid < 384) {
        const int h = item & 3, bc = item >> 2, c = bc & 31, b = bc >> 5, row0 = b * 2048 + c * 64;
        const int which = tid >> 7, cc = tid & 127, col = which * 512 + h * 128 + cc;
        const bf16_t* src = (const bf16_t*)(p.ws + OFF_QKV) + (size_t)row0 * 1536 + col;
#pragma unroll
        for (int i = 0; i < 3; ++i) r[i] = 0;
        if (c > 0) {
#pragma unroll
            for (int i = 0; i < 3; ++i) r[i] = __builtin_nontemporal_load(src + (i - 3) * 1536); }
#pragma unroll
        for (int t = 0; t < 64; ++t) r[3 + t] = __builtin_nontemporal_load(src + t * 1536);
    }
}
__device__ __forceinline__ void prep_item(const Params& p, int item, bf16_t (&r)[67], int next_item) {
    extern __shared__ __attribute__((aligned(16))) unsigned char smem[];
    float* L = (float*)smem;
    float* CQ = L; float* CK = L + 8448; float* CV = L + 16896; float* MM = L + 25344; float* GC = MM + 4096; float* BE = GC + 64; float* EG = BE + 64;
    const int tid = threadIdx.x, lane = tid & 63, wave = tid >> 6, fr = lane & 15, fq = lane >> 4;
    unsigned char* ws = p.ws;
    const bf16_t* qkv = (const bf16_t*)(ws + OFF_QKV);
    const float* betab = (const float*)(ws + OFF_BETA); const float* glb = (const float*)(ws + OFF_GL);
    float* U = (float*)(ws + OFF_U); bf16_t* WC = (bf16_t*)(ws + OFF_WC); bf16_t* QN = (bf16_t*)(ws + OFF_QN); bf16_t* KT = (bf16_t*)(ws + OFF_KT);
    bf16_t* QK = (bf16_t*)(ws + OFF_QK); float* SC = (float*)(ws + OFF_SC);
    const int h = item & 3, bc = item >> 2, c = bc & 31, b = bc >> 5; const int row0 = b * 2048 + c * 64;
    __syncthreads();
    if (tid < 384) {
        const int which = tid >> 7, cc = tid & 127, col = which * 512 + h * 128 + cc;
        const float* wcv = p.in[6];
        const float w0 = wcv[col], w1 = wcv[1536 + col], w2 = wcv[3072 + col], w3 = wcv[4608 + col];
        float* dst = L + which * 8448 + cc;
#pragma unroll
        for (int t = 0; t < 64; ++t) {
            const float y = w0 * bf2f(r[t]) + w1 * bf2f(r[t + 1]) + w2 * bf2f(r[t + 2]) + w3 * bf2f(r[t + 3]);
            dst[t * 132] = siluf_(y);
        }
        if (next_item < 1024) prep_load_raw(p, next_item, r);
    } else if (tid < 448) {
        const int t = tid - 384;
        float g = glb[(size_t)(row0 + t) * 4 + h]; const float be = betab[(size_t)(row0 + t) * 4 + h];
#pragma unroll
        for (int off = 1; off < 64; off <<= 1) { const float v = __shfl_up(g, off); if (lane >= off) g += v; }
        GC[t] = g; BE[t] = be; EG[t] = __expf(g);
    }
    __syncthreads();
    { const int rid = tid >> 2, part = tid & 3; float* src = L + (rid >> 6) * 8448 + (rid & 63) * 132 + part * 32;
      f32x4 v[8]; float ss = 0.f;
#pragma unroll
      for (int i = 0; i < 8; ++i) { v[i] = *(const f32x4*)(src + i * 4); ss += v[i][0] * v[i][0] + v[i][1] * v[i][1] + v[i][2] * v[i][2] + v[i][3] * v[i][3]; }
      ss += __shfl_xor(ss, 1); ss += __shfl_xor(ss, 2);
      const float sc = rsqrtf(ss + EPS) * (rid < 64 ? 0.08838834764831845f : 1.0f);
#pragma unroll
      for (int i = 0; i < 8; ++i) *(f32x4*)(src + i * 4) = v[i] * sc; }
    __syncthreads();
    for (int x = wave; x < 20; x += 8) {
        const bool iskk = x < 10; const int xx = iskk ? x : x - 10;
        const int ti = xx < 1 ? 0 : (xx < 3 ? 1 : (xx < 6 ? 2 : 3)); const int tj = xx - ti * (ti + 1) / 2;
        const float* Ap = (iskk ? CK : CQ) + (ti * 16 + fr) * 132 + fq * 4; const float* Bp = CK + (tj * 16 + fr) * 132 + fq * 4;
        f32x4 a4 = {0.f, 0.f, 0.f, 0.f};
#pragma unroll
        for (int k0 = 0; k0 < 128; k0 += 16) {
            const f32x4 av = *(const f32x4*)(Ap + k0), bv = *(const f32x4*)(Bp + k0);
            a4 = __builtin_amdgcn_mfma_f32_16x16x4f32(av[0], bv[0], a4, 0, 0, 0);
            a4 = __builtin_amdgcn_mfma_f32_16x16x4f32(av[1], bv[1], a4, 0, 0, 0);
            a4 = __builtin_amdgcn_mfma_f32_16x16x4f32(av[2], bv[2], a4, 0, 0, 0);
            a4 = __builtin_amdgcn_mfma_f32_16x16x4f32(av[3], bv[3], a4, 0, 0, 0);
        }
#pragma unroll
        for (int j = 0; j < 4; ++j) {
            const int i = ti * 16 + fq * 4 + j, jj = tj * 16 + fr;
            const float v = a4[j] * __expf(fminf(GC[i] - GC[jj], 0.f));
            if (iskk) MM[i * 64 + jj] = (i > jj) ? v * BE[i] : 0.f;
            else QK[(size_t)item * 4096 + fragoff(i, jj, 2)] = f2bf((i >= jj) ? v : 0.f);
        }
    }
    for (int idx = tid; idx < 1536; idx += NTHR) {
        const int u = idx >> 8; const int ti = u < 3 ? 0 : (u < 5 ? 1 : 2); const int tj = u < 3 ? u + 1 : (u < 5 ? u - 1 : 3);
        const int r = (idx & 255) >> 4, ci = idx & 15;
        QK[(size_t)item * 4096 + fragoff(ti * 16 + r, tj * 16 + ci, 2)] = 0;
    }
    { const int t = tid >> 3, d0 = (tid & 7) * 16; const float* src = CQ + t * 132 + d0;
      const f32x4 a = *(const f32x4*)src, b4 = *(const f32x4*)(src + 4), c4 = *(const f32x4*)(src + 8), d4 = *(const f32x4*)(src + 12);
      u32x4 w0, w1; w0.x = cvt_pk_bf16(a[0], a[1]); w0.y = cvt_pk_bf16(a[2], a[3]); w0.z = cvt_pk_bf16(b4[0], b4[1]); w0.w = cvt_pk_bf16(b4[2], b4[3]);
      w1.x = cvt_pk_bf16(c4[0], c4[1]); w1.y = cvt_pk_bf16(c4[2], c4[3]); w1.z = cvt_pk_bf16(d4[0], d4[1]); w1.w = cvt_pk_bf16(d4[2], d4[3]);
      bf16_t* dst = QN + (size_t)item * 8192; *(u32x4*)(dst + fragoff(t, d0, 4)) = w0; *(u32x4*)(dst + fragoff(t, d0 + 8, 4)) = w1; }
    { const int d = tid >> 2, t0 = (tid & 3) * 16; float v[16];
#pragma unroll
      for (int i = 0; i < 16; ++i) v[i] = CK[(t0 + i) * 132 + d];
      u32x4 w0, w1; w0.x = cvt_pk_bf16(v[0], v[1]); w0.y = cvt_pk_bf16(v[2], v[3]); w0.z = cvt_pk_bf16(v[4], v[5]); w0.w = cvt_pk_bf16(v[6], v[7]);
      w1.x = cvt_pk_bf16(v[8], v[9]); w1.y = cvt_pk_bf16(v[10], v[11]); w1.z = cvt_pk_bf16(v[12], v[13]); w1.w = cvt_pk_bf16(v[14], v[15]);
      bf16_t* dst = KT + (size_t)item * 8192; *(u32x4*)(dst + fragoff(d, t0, 2)) = w0; *(u32x4*)(dst + fragoff(d, t0 + 8, 2)) = w1; }
    if (tid < 64) { SC[(size_t)item * 132 + tid] = EG[tid]; SC[(size_t)item * 132 + 64 + tid] = __expf(GC[63] - GC[tid]); if (tid == 0) SC[(size_t)item * 132 + 128] = EG[63]; }
    __syncthreads();
    for (int idx = tid; idx < 64 * 128; idx += NTHR) { const int i = idx >> 7, cc = idx & 127; const float be = BE[i]; CV[i * 132 + cc] *= be; CK[i * 132 + cc] *= be * EG[i]; }
    __syncthreads();
#pragma unroll 1
    for (int ib = 0; ib < 4; ++ib) {
        if (ib > 0) {
#pragma unroll 1
            for (int q = 0; q < 2; ++q) {
                const int ntile = wave * 2 + q; float* Rb = (ntile < 8 ? CV : CK) + (ntile & 7) * 16;
                f32x4 a4;
#pragma unroll
                for (int j = 0; j < 4; ++j) a4[j] = Rb[(ib * 16 + fq * 4 + j) * 132 + fr];
#pragma unroll 1
                for (int jb = 0; jb < ib; ++jb) {
#pragma unroll
                    for (int ks = 0; ks < 4; ++ks) {
                        const float av = -MM[(ib * 16 + fr) * 64 + jb * 16 + ks * 4 + fq];
                        const float bv = Rb[(jb * 16 + ks * 4 + fq) * 132 + fr];
                        a4 = __builtin_amdgcn_mfma_f32_16x16x4f32(av, bv, a4, 0, 0, 0);
                    }
                }
#pragma unroll
                for (int j = 0; j < 4; ++j) Rb[(ib * 16 + fq * 4 + j) * 132 + fr] = a4[j];
            }
            __syncthreads();
        }
        if (tid < 256) {
            float* Rb = (tid < 128 ? CV : CK) + (tid & 127) + ib * 16 * 132; const float* Mb = MM + (ib * 16) * 64 + ib * 16;
            float x[16];
#pragma unroll
            for (int i = 0; i < 16; ++i) {
                float a = Rb[i * 132];
#pragma unroll
                for (int j = 0; j < i; ++j) a -= Mb[i * 64 + j] * x[j];
                x[i] = a;
            }
#pragma unroll
            for (int i = 0; i < 16; ++i) Rb[i * 132] = x[i];
        }
        __syncthreads();
    }
#pragma unroll
    for (int k = 0; k < 4; ++k) { const int idx = tid + k * NTHR; const int i = idx >> 5, c4 = (idx & 31) * 4;
        const f32x4 uv = *(const f32x4*)(CV + i * 132 + c4); *(f32x4*)(U + (size_t)item * 8192 + i * 128 + c4) = uv;
        const f32x4 wv = *(const f32x4*)(CK + i * 132 + c4); u32x2 w; w.x = cvt_pk_bf16(wv[0], wv[1]); w.y = cvt_pk_bf16(wv[2], wv[3]);
        *(u32x2*)(WC + (size_t)item * 8192 + fragoff(i, c4, 4)) = w; }
}

__device__ void phase2(const Params& p) {
    bf16_t r[67];
    if ((int)blockIdx.x < 1024) prep_load_raw(p, blockIdx.x, r);
    for (int item = blockIdx.x; item < 1024; item += gridDim.x) prep_item(p, item, r, item + (int)gridDim.x);
}

constexpr int SL_SB = 0, SL_VN = 4352, SL_VS = 6656;
struct ScanRegs { bf16x8 a4[4]; bf16x8 aK[2]; bf16x8 aX[2]; f32x4 x4; f32x4 u4; float last; };
struct ScanPtrs { const char* pA; const char* pK; const char* pQ; const char* pU; const char* pS; int next; int rowoff; };
__device__ __forceinline__ void scan_load(ScanRegs& R, ScanPtrs& P, int role) {
#pragma unroll
    for (int ks = 0; ks < 4; ++ks) R.a4[ks] = *(const bf16x8*)(P.pA + ks * 1024);
    R.aK[0] = *(const bf16x8*)(P.pK); R.aK[1] = *(const bf16x8*)(P.pK + 1024);
    R.x4 = *(const f32x4*)(P.pS + (role ? 0 : 256));
    R.last = *(const float*)(P.pS + 512 - P.rowoff);
    R.aX[0] = *(const bf16x8*)(P.pQ); R.aX[1] = *(const bf16x8*)(P.pQ + 1024);
    R.u4[0] = *(const float*)(P.pU); R.u4[1] = *(const float*)(P.pU + 512); R.u4[2] = *(const float*)(P.pU + 1024); R.u4[3] = *(const float*)(P.pU + 1536);
    const bool adv = P.next < 31;
    P.pA += adv ? 65536 : 0; P.pK += adv ? 65536 : 0; P.pQ += adv ? 32768 : 0; P.pU += adv ? 131072 : 0; P.pS += adv ? 2112 : 0; P.next += adv ? 1 : 0;
}
__device__ __forceinline__ void scan_chunk(const ScanRegs& R, f32x4& S, float*& pO, LAS unsigned char* lds, int role, int mt, int wave, int fr, int fq) {
    f32x4 acc = {0.f, 0.f, 0.f, 0.f};
#pragma unroll
    for (int ks = 0; ks < 4; ++ks) { const bf16x8 sb = *(const LAS bf16x8*)(lds + SL_SB + fr * 272 + (ks * 32 + fq * 8) * 2);
        acc = __builtin_amdgcn_mfma_f32_16x16x32_bf16(R.a4[ks], sb, acc, 0, 0, 0); }
    if (!role) {
        float vn[4], vs[4];
#pragma unroll
        for (int j = 0; j < 4; ++j) { vn[j] = R.u4[j] - acc[j]; vs[j] = vn[j] * R.x4[j]; }
        u32x2 wn_, ws_; wn_.x = cvt_pk_bf16(vn[0], vn[1]); wn_.y = cvt_pk_bf16(vn[2], vn[3]); ws_.x = cvt_pk_bf16(vs[0], vs[1]); ws_.y = cvt_pk_bf16(vs[2], vs[3]);
        *(LAS u32x2*)(lds + SL_VN + (fr * 72 + mt * 16 + fq * 4) * 2) = wn_;
        *(LAS u32x2*)(lds + SL_VS + (fr * 72 + mt * 16 + fq * 4) * 2) = ws_;
    } else {
#pragma unroll
        for (int j = 0; j < 4; ++j) acc[j] *= R.x4[j];
    }
    __syncthreads();
    {
        const bf16x8 v0 = *(const LAS bf16x8*)(lds + SL_VS + fr * 144 + (fq * 8) * 2), v1 = *(const LAS bf16x8*)(lds + SL_VS + fr * 144 + (32 + fq * 8) * 2);
        S = S * R.last;
        S = __builtin_amdgcn_mfma_f32_16x16x32_bf16(R.aK[0], v0, S, 0, 0, 0);
        S = __builtin_amdgcn_mfma_f32_16x16x32_bf16(R.aK[1], v1, S, 0, 0, 0);
        u32x2 w; w.x = pk_bf16_c(S[0], S[1]); w.y = pk_bf16_c(S[2], S[3]);
        *(LAS u32x2*)(lds + SL_SB + (fr * 136 + wave * 16 + fq * 4) * 2) = w;
    }
    if (role) {
        const bf16x8 n0 = *(const LAS bf16x8*)(lds + SL_VN + fr * 144 + (fq * 8) * 2), n1 = *(const LAS bf16x8*)(lds + SL_VN + fr * 144 + (32 + fq * 8) * 2);
        acc = __builtin_amdgcn_mfma_f32_16x16x32_bf16(R.aX[0], n0, acc, 0, 0, 0);
        acc = __builtin_amdgcn_mfma_f32_16x16x32_bf16(R.aX[1], n1, acc, 0, 0, 0);
        pO[0] = acc[0]; pO[16] = acc[1]; pO[32] = acc[2]; pO[48] = acc[3];
    }
    pO += 32768;
    __syncthreads();
}
__device__ void scan_slice(const Params& p, int wi) {
    extern __shared__ __attribute__((aligned(16))) unsigned char smem[];
    LAS unsigned char* lds = (LAS unsigned char*)smem;
    const int tid = threadIdx.x, lane = tid & 63, wave = __builtin_amdgcn_readfirstlane(tid >> 6), fr = lane & 15, fq = lane >> 4;
    const int seq = wi >> 3, slice = wi & 7, b = seq >> 2, h = seq & 3, e0 = slice * 16, role = wave >> 2, mt = wave & 3;
    unsigned char* ws = p.ws;
    __syncthreads();
    for (int i = tid; i < 4352 / 4; i += NTHR) *(LAS unsigned*)(lds + SL_SB + i * 4) = 0u;
    f32x4 S = {0.f, 0.f, 0.f, 0.f};
    const size_t item0 = (size_t)((b * 32) * 4 + h);
    ScanPtrs P;
    P.pA = (const char*)((role ? (const bf16_t*)(ws + OFF_QN) : (const bf16_t*)(ws + OFF_WC)) + item0 * 8192 + (mt * 4) * 512 + lane * 8);
    P.pK = (const char*)((const bf16_t*)(ws + OFF_KT) + item0 * 8192 + (wave * 2) * 512 + lane * 8);
    P.pQ = (const char*)((const bf16_t*)(ws + OFF_QK) + item0 * 4096 + (mt * 2) * 512 + lane * 8);
    P.pU = (const char*)((const float*)(ws + OFF_U) + item0 * 8192 + (mt * 16 + fq * 4) * 128 + e0 + fr);
    P.pS = (const char*)((const float*)(ws + OFF_SC) + item0 * 132 + mt * 16 + fq * 4);
    P.next = 0; P.rowoff = (mt * 16 + fq * 4) * 4;
    float* pO = (float*)(ws + OFF_ORAW) + ((item0 * 8 + slice) * 64 + mt * 16 + fq * 4) * 16 + fr;
    ScanRegs R0, R1;
    scan_load(R0, P, role); scan_load(R1, P, role);
    __syncthreads();
#pragma unroll 1
    for (int c = 0; c < 32; c += 2) {
        scan_chunk(R0, S, pO, lds, role, mt, wave, fr, fq); scan_load(R0, P, role);
        scan_chunk(R1, S, pO, lds, role, mt, wave, fr, fq); scan_load(R1, P, role);
    }
    float* So = (float*)(p.ws + OFF_SFIN) + (size_t)wi * 2048 + (wave * 16 + fq * 4) * 16 + fr;
    So[0] = S[0]; So[16] = S[1]; So[32] = S[2]; So[48] = S[3];
}

__device__ void phase3b(const Params& p) {
    unsigned char* ws = p.ws;
    const float* OR = (const float*)(ws + OFF_ORAW); const float* SSQP = (const float*)(ws + OFF_SSQP);
    const bf16_t* zb = (const bf16_t*)(ws + OFF_ZB); bf16_t* OA = (bf16_t*)(ws + OFF_OA); const float* wn = p.in[9];
    {
        const int wv = threadIdx.x >> 6, ln = threadIdx.x & 63;
        for (int row = blockIdx.x * 8 + wv; row < T_P; row += gridDim.x * 8) {
            const int c8 = ln * 8, h = c8 >> 7, e = c8 & 127;
            const int bb = row >> 11, t = row & 2047; const size_t item = (size_t)((bb * 32 + (t >> 6)) * 4 + h);
            const float* src = OR + ((item * 8 + (e >> 4)) * 64 + (t & 63)) * 16 + (e & 15);
            const f32x4 o0 = __builtin_nontemporal_load((const f32x4*)src), o1 = __builtin_nontemporal_load((const f32x4*)(src + 4));
            float ss = (o0[0] * o0[0] + o0[1] * o0[1]) + (o0[2] * o0[2] + o0[3] * o0[3]) + (o1[0] * o1[0] + o1[1] * o1[1]) + (o1[2] * o1[2] + o1[3] * o1[3]);
            ss += __shfl_xor(ss, 1); ss += __shfl_xor(ss, 2); ss += __shfl_xor(ss, 4); ss += __shfl_xor(ss, 8);
            const float rs = rsqrtf(ss * (1.0f / 128.0f) + EPS);
            const u32x4 z = __builtin_nontemporal_load((const u32x4*)(zb + (size_t)row * 512 + c8));
            const f32x4 w0 = *(const f32x4*)(wn + e), w1 = *(const f32x4*)(wn + e + 4);
            u32x4 w; w.x = cvt_pk_bf16(o0[0] * rs * w0[0] * siluf_(bflo(z.x)), o0[1] * rs * w0[1] * siluf_(bfhi(z.x)));
            w.y = cvt_pk_bf16(o0[2] * rs * w0[2] * siluf_(bflo(z.y)), o0[3] * rs * w0[3] * siluf_(bfhi(z.y)));
            w.z = cvt_pk_bf16(o1[0] * rs * w1[0] * siluf_(bflo(z.z)), o1[1] * rs * w1[1] * siluf_(bfhi(z.z)));
            w.w = cvt_pk_bf16(o1[2] * rs * w1[2] * siluf_(bflo(z.w)), o1[3] * rs * w1[3] * siluf_(bfhi(z.w)));
            *(u32x4*)(OA + (size_t)row * 512 + c8) = w;
        }
        (void)SSQP;
    }
    { const float* SF = (const float*)(ws + OFF_SFIN); float* So = p.out + O_SSMP;
      for (int idx = blockIdx.x * NTHR + threadIdx.x; idx < 32 * 128 * 32; idx += gridDim.x * NTHR) {
          const int e4 = (idx & 31) * 4, dk = (idx >> 5) & 127, seq = idx >> 12;
          *(f32x4*)(So + (size_t)seq * 16384 + dk * 128 + e4) = *(const f32x4*)(SF + (size_t)(seq * 8 + (e4 >> 4)) * 2048 + dk * 16 + (e4 & 15)); } }
}

__device__ void sample_item(const Params& p, int it) {
    extern __shared__ __attribute__((aligned(16))) unsigned char smem[];
    float* L = (float*)smem;
    float* CQ = L; float* CK = L + 1024; float* CV = L + 2048; float* A8 = L + 3072; float* B8 = L + 3080; float* KQ = L + 3088; float* RED = L + 3104; float* OL = L + 4128;
    const int tid = threadIdx.x, lane = tid & 63, wave = tid >> 6;
    unsigned char* ws = p.ws;
    const bf16_t* qkv = (const bf16_t*)(ws + OFF_QKV); const bf16_t* zb = (const bf16_t*)(ws + OFF_ZB); bf16_t* OA = (bf16_t*)(ws + OFF_OA);
    const float* betab = (const float*)(ws + OFF_BETA); const float* glb = (const float*)(ws + OFF_GL);
    const int b = it >> 2, h = it & 3, row0 = T_P + b * 8;
    const int e = tid & 127, qd = tid >> 7;
    float S[32];
    { const float* s0p = p.in[4] + ((size_t)(b * 4 + h) * 128 + qd * 32) * 128 + e;
#pragma unroll
      for (int i = 0; i < 32; ++i) S[i] = __builtin_nontemporal_load(s0p + i * 128); }
    __syncthreads();
    if (tid < 384) {
        const int which = tid >> 7, cc = tid & 127, col = which * 512 + h * 128 + cc;
        const float* wcv = p.in[6]; const float* sc = p.in[2];
        const float w0 = wcv[col], w1 = wcv[1536 + col], w2 = wcv[3072 + col], w3 = wcv[4608 + col];
        float r0 = sc[((size_t)b * 3 + 0) * 1536 + col], r1 = sc[((size_t)b * 3 + 1) * 1536 + col], r2 = sc[((size_t)b * 3 + 2) * 1536 + col];
        float* dst = L + which * 1024 + cc;
#pragma unroll
        for (int t = 0; t < 8; ++t) {
            const float r3 = bf2f(qkv[(size_t)(row0 + t) * 1536 + col]);
            const float y = w0 * r0 + w1 * r1 + w2 * r2 + w3 * r3;
            dst[t * 128] = siluf_(y);
            r0 = r1; r1 = r2; r2 = r3;
        }
    } else if (tid < 392) {
        const int t = tid - 384;
        A8[t] = __expf(glb[(size_t)(row0 + t) * 4 + h]); B8[t] = betab[(size_t)(row0 + t) * 4 + h];
    }
    __syncthreads();
    { const int rid = tid >> 5, part = tid & 31; float* src = L + (rid >> 3) * 1024 + (rid & 7) * 128 + part * 4;
      f32x4 v = *(const f32x4*)src; float ss = v[0] * v[0] + v[1] * v[1] + v[2] * v[2] + v[3] * v[3];
      ss += __shfl_xor(ss, 1); ss += __shfl_xor(ss, 2); ss += __shfl_xor(ss, 4); ss += __shfl_xor(ss, 8); ss += __shfl_xor(ss, 16);
      const float sc = rsqrtf(ss + EPS) * (rid < 8 ? 0.08838834764831845f : 1.0f);
      *(f32x4*)src = v * sc; }
    __syncthreads();
    { const int t = wave; float kq = CK[t * 128 + lane] * CQ[t * 128 + lane] + CK[t * 128 + 64 + lane] * CQ[t * 128 + 64 + lane];
#pragma unroll
      for (int off = 1; off < 64; off <<= 1) kq += __shfl_xor(kq, off);
      if (lane == 0) KQ[t] = kq; }
    __syncthreads();
#pragma unroll 1
    for (int t = 0; t < 8; ++t) {
        float r = 0.f, pp = 0.f;
#pragma unroll
        for (int i = 0; i < 32; ++i) { r += CK[t * 128 + qd * 32 + i] * S[i]; pp += CQ[t * 128 + qd * 32 + i] * S[i]; }
        RED[(qd * 128 + e) * 2] = r; RED[(qd * 128 + e) * 2 + 1] = pp;
        __syncthreads();
        r = (RED[e * 2] + RED[(128 + e) * 2]) + (RED[(256 + e) * 2] + RED[(384 + e) * 2]);
        pp = (RED[e * 2 + 1] + RED[(128 + e) * 2 + 1]) + (RED[(256 + e) * 2 + 1] + RED[(384 + e) * 2 + 1]);
        const float a = A8[t], be = B8[t];
        const float delta = be * (CV[t * 128 + e] - a * r);
        const float o = a * pp + KQ[t] * delta;
#pragma unroll
        for (int i = 0; i < 32; ++i) S[i] = a * S[i] + CK[t * 128 + qd * 32 + i] * delta;
        if (qd == 0) OL[t * 128 + e] = o;
        __syncthreads();
    }
    { float* so = p.out + O_SSMS + ((size_t)(b * 4 + h) * 128 + qd * 32) * 128 + e;
#pragma unroll
      for (int i = 0; i < 32; ++i) so[i * 128] = S[i]; }
    { const int t = wave; const float o0 = OL[t * 128 + lane], o1 = OL[t * 128 + 64 + lane]; float ss = o0 * o0 + o1 * o1;
#pragma unroll
      for (int off = 1; off < 64; off <<= 1) ss += __shfl_xor(ss, off);
      const float rs = rsqrtf(ss * (1.0f / 128.0f) + EPS);
      const float z0 = bf2f(zb[(size_t)(row0 + t) * 512 + h * 128 + lane]), z1 = bf2f(zb[(size_t)(row0 + t) * 512 + h * 128 + 64 + lane]);
      OA[(size_t)(row0 + t) * 512 + h * 128 + lane] = f2bf(o0 * rs * p.in[9][lane] * siluf_(z0));
      OA[(size_t)(row0 + t) * 512 + h * 128 + 64 + lane] = f2bf(o1 * rs * p.in[9][64 + lane] * siluf_(z1)); }
}

template <int WIN, int NR>
__device__ __forceinline__ void pool_seq(const bf16_t* __restrict__ pb, bf16_t* __restrict__ PL, const float* __restrict__ sp, int base, int t0, int b, bool isS, int col) {
    float v[NR + WIN - 1];
#pragma unroll
    for (int i = 0; i < NR + WIN - 1; ++i) { const int t = t0 - (WIN - 1) + i;
        float x = 0.f;
        if (t >= 0) x = bf2f(__builtin_nontemporal_load(pb + (size_t)(base + t) * 512 + col));
        else if (isS) x = sp[((size_t)b * 15 + 15 + t) * 512 + col];
        v[i] = x; }
    float sum = 0.f;
#pragma unroll
    for (int s2 = 0; s2 < WIN - 1; ++s2) sum += v[s2];
#pragma unroll
    for (int r = 0; r < NR; ++r) { const int t = t0 + r;
        sum += v[r + WIN - 1];
        const int cnt = isS ? WIN : (t + 1 < WIN ? t + 1 : WIN);
        PL[(size_t)(base + t) * 512 + col] = f2bf(sum * __builtin_amdgcn_rcpf((float)cnt) - v[r + WIN - 1]);
        sum -= v[r]; }
}
__device__ void pool_item(const Params& p, int pt) {
    const int col = threadIdx.x, gi = col >> 7;
    const bf16_t* pb = (const bf16_t*)(p.ws + OFF_PB); bf16_t* PL = (bf16_t*)(p.ws + OFF_PL);
    const float* sp = p.in[3];
    if (pt < 256) {
        const int b = pt >> 5, t0 = (pt & 31) * 64, base = b * 2048;
        if (gi == 0) pool_seq<2, 64>(pb, PL, sp, base, t0, b, false, col);
        else if (gi == 1) pool_seq<4, 64>(pb, PL, sp, base, t0, b, false, col);
        else if (gi == 2) pool_seq<8, 64>(pb, PL, sp, base, t0, b, false, col);
        else pool_seq<16, 64>(pb, PL, sp, base, t0, b, false, col);
    } else {
#pragma unroll 1
        for (int q = 0; q < 8; ++q) { const int b = (pt - 256) * 8 + q, base = T_P + b * 8;
            if (gi == 0) pool_seq<2, 8>(pb, PL, sp, base, 0, b, true, col);
            else if (gi == 1) pool_seq<4, 8>(pb, PL, sp, base, 0, b, true, col);
            else if (gi == 2) pool_seq<8, 8>(pb, PL, sp, base, 0, b, true, col);
            else pool_seq<16, 8>(pb, PL, sp, base, 0, b, true, col); }
    }
}

__device__ void phase3(const Params& p) {
    if (gridDim.x == 256) {
        const int cb = blockIdx.x, xcd = cb & 7, q = cb >> 3;
        scan_slice(p, (xcd * 4 + (q >> 3)) * 8 + (q & 7));
    } else {
        for (int wi = blockIdx.x; wi < 256; wi += gridDim.x) scan_slice(p, wi);
    }
    for (int it = blockIdx.x; it < 784; it += gridDim.x) { if (it < 512) sample_item(p, it); else pool_item(p, it - 512); }
}

struct EpiP4 {
    const bf16_t* sga; const bf16_t* sgb; bf16_t* MG;
    __device__ __forceinline__ bool operator()(acc_t& acc, int pm, int pn, int wr, int wc, int fr, int fq, int ui) const {
        if ((ui & 1) == 0) {
            EPI_ROWS(
                _Pragma("unroll") for (int bj = 0; bj < 2; ++bj) { const int col = pn * 256 + bj * 128 + wc * 32 + fq * 8;
                    const u32x4 ga = *(const u32x4*)(sga + (size_t)row * 1024 + col); const u32x4 gb = *(const u32x4*)(sgb + (size_t)row * 1024 + col);
                    f32x4 r0; f32x4 r1;
                    r0[0] = bflo(ga.x) * __builtin_amdgcn_rcpf(bflo(gb.x)); r0[1] = bfhi(ga.x) * __builtin_amdgcn_rcpf(bfhi(gb.x)); r0[2] = bflo(ga.y) * __builtin_amdgcn_rcpf(bflo(gb.y)); r0[3] = bfhi(ga.y) * __builtin_amdgcn_rcpf(bfhi(gb.y));
                    r1[0] = bflo(ga.z) * __builtin_amdgcn_rcpf(bflo(gb.z)); r1[1] = bfhi(ga.z) * __builtin_amdgcn_rcpf(bfhi(gb.z)); r1[2] = bflo(ga.w) * __builtin_amdgcn_rcpf(bflo(gb.w)); r1[3] = bfhi(ga.w) * __builtin_amdgcn_rcpf(bfhi(gb.w));
                    acc[ai][bj][m][0] = acc[ai][bj][m][0] * r0; acc[ai][bj][m][1] = acc[ai][bj][m][1] * r1; }
            )
            return true;
        }
        EPI_ROWS(
            EPI_COLS8(
                const u32x4 g = *(const u32x4*)(sgb + (size_t)row * 1024 + col);
                f32x4 v0 = a0; f32x4 v1 = a1;
                v0[0] *= bflo(g.x); v0[1] *= bfhi(g.x); v0[2] *= bflo(g.y); v0[3] *= bfhi(g.y);
                v1[0] *= bflo(g.z); v1[1] *= bfhi(g.z); v1[2] *= bflo(g.w); v1[3] *= bfhi(g.w);
                *(u32x4*)(MG + (size_t)row * 1024 + col) = pack8(v0, v1);
            )
        )
        return false;
    }
};
__device__ void phase4(const Params& p) {
    unsigned char* ws = p.ws;
    const bf16_t* sga = (const bf16_t*)(p.out + O_Y); const bf16_t* sgb = sga + (size_t)T_ALL * 1024;
    EpiP4 E{sga, sgb, (bf16_t*)(ws + OFF_QKV)};
    SchedTwoPass SD{T_ALL / 256, 4, 512 / 64, (int)gridDim.x, (int)blockIdx.x};
    gemm_phase<EpiP4, SchedTwoPass>((const bf16_t*)(ws + OFF_OA), (const bf16_t*)(ws + OFF_WAT), 512, SD, E, (const bf16_t*)(ws + OFF_PL), (const bf16_t*)(ws + OFF_WBT));
}

struct EpiP5 {
    const float* xp; const float* xs; float* x1; bf16_t* x1b; float* ssq;
    __device__ __forceinline__ bool operator()(acc_t& acc, int pm, int pn, int wr, int wc, int fr, int fq, int ui) const {
        EPI_ROWS(
            const float* xr = row < T_P ? xp + (size_t)row * DM : xs + (size_t)(row - T_P) * DM;
            float s = 0.f;
            EPI_COLS8(
                const f32x4 v0 = *(const f32x4*)(xr + col) + a0; const f32x4 v1 = *(const f32x4*)(xr + col + 4) + a1;
                *(u32x4*)(x1b + (size_t)row * 1024 + col) = pack8(v0, v1);
                s += ((v0[0] * v0[0] + v0[1] * v0[1]) + (v0[2] * v0[2] + v0[3] * v0[3])) + ((v1[0] * v1[0] + v1[1] * v1[1]) + (v1[2] * v1[2] + v1[3] * v1[3]));
            )
            s += __shfl_xor(s, 16); s += __shfl_xor(s, 32);
            if (fq == 0) ssq[(size_t)row * 16 + pn * 4 + wc] = s;
        )
        return false;
    }
};
__device__ void phase5(const Params& p) {
    unsigned char* ws = p.ws;
    EpiP5 E{p.in[0], p.in[1], p.out + O_Y, (bf16_t*)(ws + OFF_R1), (float*)(ws + OFF_SSQ2)};
    SchedStatic SD{T_ALL / 256, 4, 1024 / 64, (int)gridDim.x, (int)blockIdx.x};
    gemm_phase<EpiP5, SchedStatic>((const bf16_t*)(ws + OFF_QKV), (const bf16_t*)(ws + OFF_WOT), 1024, SD, E);
}

__device__ __forceinline__ float rstd_from16(const float* q) {
    const f32x4 a = *(const f32x4*)q, b = *(const f32x4*)(q + 4), c = *(const f32x4*)(q + 8), d = *(const f32x4*)(q + 12);
    const float t = ((a[0] + a[1]) + (a[2] + a[3])) + ((b[0] + b[1]) + (b[2] + b[3])) + ((c[0] + c[1]) + (c[2] + c[3])) + ((d[0] + d[1]) + (d[2] + d[3]));
    return rsqrtf(t * (1.0f / 1024.0f) + EPS);
}

struct EpiP6 {
    const float* ssq; bf16_t* HM;
    __device__ __forceinline__ bool operator()(acc_t& acc, int pm, int pn, int wr, int wc, int fr, int fq, int ui) const {
        EPI_ROWS(
            const float rs = rstd_from16(ssq + (size_t)row * 16);
            EPI_COLS8(
                f32x4 v0 = a0 * rs; f32x4 v1 = a1 * rs;
                v0[0] = fmaxf(v0[0], 0.f); v0[1] = fmaxf(v0[1], 0.f); v0[2] = fmaxf(v0[2], 0.f); v0[3] = fmaxf(v0[3], 0.f);
                v1[0] = fmaxf(v1[0], 0.f); v1[1] = fmaxf(v1[1], 0.f); v1[2] = fmaxf(v1[2], 0.f); v1[3] = fmaxf(v1[3], 0.f);
                *(u32x4*)(HM + (size_t)row * 4096 + col) = pack8(v0 * v0, v1 * v1);
            )
        )
        return false;
    }
};
__device__ void phase6(const Params& p) {
    unsigned char* ws = p.ws;
    EpiP6 E{(const float*)(ws + OFF_SSQ2), (bf16_t*)(ws + OFF_HMID)};
    SchedStatic SD{T_ALL / 256, 16, 1024 / 64, (int)gridDim.x, (int)blockIdx.x};
    gemm_phase<EpiP6, SchedStatic>((const bf16_t*)(ws + OFF_R1), (const bf16_t*)(ws + OFF_WUT), 1024, SD, E);
}

struct EpiP7 {
    bf16_t* x1b; bf16_t* part; int sk;
    __device__ __forceinline__ bool operator()(acc_t& acc, int pm, int pn, int wr, int wc, int fr, int fq, int ui) const {
        if (!sk || ui == 0) {
            EPI_ROWS(
                EPI_COLS8(
                    u32x4* px = (u32x4*)(x1b + (size_t)row * 1024 + col);
                    const u32x4 xr = *px;
                    f32x4 v0 = a0; f32x4 v1 = a1;
                    v0[0] += bflo(xr.x); v0[1] += bfhi(xr.x); v0[2] += bflo(xr.y); v0[3] += bfhi(xr.y);
                    v1[0] += bflo(xr.z); v1[1] += bfhi(xr.z); v1[2] += bflo(xr.w); v1[3] += bfhi(xr.w);
                    *px = pack8(v0, v1);
                )
            )
        } else {
            EPI_ROWS(
                EPI_COLS8(
                    u32x4 w; w.x = pk_bf16_c(a0[0], a0[1]); w.y = pk_bf16_c(a0[2], a0[3]); w.z = pk_bf16_c(a1[0], a1[1]); w.w = pk_bf16_c(a1[2], a1[3]);
                    *(u32x4*)(part + (size_t)row * 1024 + col) = w;
                )
            )
        }
        return false;
    }
};
__device__ __forceinline__ int sk_per(int G) {
    const int ntK = 4096 / 64, tot = (T_ALL / 256) * 4 * ntK;
    return (tot % G == 0 && ((tot / G) & 3) == 0 && (tot / G) > ntK && (tot / G) <= 2 * ntK && (G & 31) == 0) ? tot / G : 0;
}
__device__ void phase7(const Params& p) {
    unsigned char* ws = p.ws;
    const int G = gridDim.x, ntK = 4096 / 64, per = sk_per(G);
    EpiP7 E{(bf16_t*)(ws + OFF_R1), (bf16_t*)(ws + OFF_PART), per};
    if (per) {
        const int cb = blockIdx.x, xcd = cb & 7, q = cb >> 3;
        SchedStreamK SD{q & 3, ntK, per, xcd * (G >> 5) + (q >> 2)};
        gemm_phase<EpiP7, SchedStreamK>((const bf16_t*)(ws + OFF_HMID), (const bf16_t*)(ws + OFF_WDT), 4096, SD, E);
    } else {
        SchedStatic SD{T_ALL / 256, 4, ntK, G, (int)blockIdx.x};
        gemm_phase<EpiP7, SchedStatic>((const bf16_t*)(ws + OFF_HMID), (const bf16_t*)(ws + OFF_WDT), 4096, SD, E);
    }
}

__device__ void phase8(const Params& p) {
    const int tid = threadIdx.x, wave = tid >> 6, lane = tid & 63;
    const float* gf = p.in[19]; float* y = p.out + O_Y; const bf16_t* part = (const bf16_t*)(p.ws + OFF_PART); const bf16_t* x1b = (const bf16_t*)(p.ws + OFF_R1);
    const int per = sk_per(gridDim.x);
    f32x4 g[4];
#pragma unroll
    for (int i = 0; i < 4; ++i) g[i] = *(const f32x4*)(gf + i * 256 + lane * 4);
#define P8_LOAD(dst, r_) do { _Pragma("unroll") for (int i = 0; i < 4; ++i) { const u32x2 xw = __builtin_nontemporal_load((const u32x2*)(x1b + (size_t)(r_) * 1024 + i * 256 + lane * 4)); \
            dst[i][0] = bflo(xw.x); dst[i][1] = bfhi(xw.x); dst[i][2] = bflo(xw.y); dst[i][3] = bfhi(xw.y); } } while (0)
    int row = blockIdx.x * 8 + wave;
    f32x4 cur[4];
    if (row < T_ALL) P8_LOAD(cur, row);
    while (row < T_ALL) {
        const int nrow = row + gridDim.x * 8;
        f32x4 nxt[4];
        if (nrow < T_ALL) P8_LOAD(nxt, nrow);
        if (per && (((row >> 8) * 64) % per != 0)) {
#pragma unroll
            for (int i = 0; i < 4; ++i) { const u32x2 pw = __builtin_nontemporal_load((const u32x2*)(part + (size_t)row * 1024 + i * 256 + lane * 4));
                cur[i][0] += bflo(pw.x); cur[i][1] += bfhi(pw.x); cur[i][2] += bflo(pw.y); cur[i][3] += bfhi(pw.y); } }
        float ss = 0.f;
#pragma unroll
        for (int i = 0; i < 4; ++i) ss += (cur[i][0] * cur[i][0] + cur[i][1] * cur[i][1]) + (cur[i][2] * cur[i][2] + cur[i][3] * cur[i][3]);
#pragma unroll
        for (int off = 1; off < 64; off <<= 1) ss += __shfl_xor(ss, off);
        const float rs = rsqrtf(ss * (1.0f / 1024.0f) + EPS);
#pragma unroll
        for (int i = 0; i < 4; ++i) *(f32x4*)(y + (size_t)row * 1024 + i * 256 + lane * 4) = cur[i] * rs * g[i];
#pragma unroll
        for (int i = 0; i < 4; ++i) cur[i] = nxt[i];
        row = nrow;
    }
#undef P8_LOAD
}

__global__ void __launch_bounds__(NTHR, 2) hybrid_fwd(Params p) {
    cg::grid_group grid = cg::this_grid();
    extern __shared__ __attribute__((aligned(16))) unsigned char smem[];
    volatile LAS unsigned* st = (volatile LAS unsigned*)((LAS unsigned char*)smem + 131072);
    if (threadIdx.x < 4) st[threadIdx.x] = 0u;
    __syncthreads();
    if (p.ws == nullptr) grid.sync();
    XcdBarrier bar = xcd_barrier_post((unsigned*)(p.ws + OFF_BAR), st);
#ifndef ONLY
#define ONLY -1
#endif
#define PH(n) if (ONLY < 0 || ONLY == n)
    PH(0) phase0(p); xcd_barrier(bar);
    PH(1) phase1(p); xcd_barrier(bar);
    PH(2) phase2(p); xcd_barrier(bar);
    PH(3) phase3(p); xcd_barrier(bar);
    PH(3) phase3b(p); xcd_barrier(bar);
    PH(4) phase4(p); xcd_barrier(bar);
    PH(5) phase5(p); xcd_barrier(bar);
    PH(6) phase6(p); xcd_barrier(bar);
    PH(7) phase7(p); xcd_barrier(bar);
    PH(8) phase8(p);
}

extern "C" void kernel_launch(void* const* d_in, const int* in_sizes, int n_in, void* d_out, int out_size, void* d_ws, size_t ws_size, hipStream_t stream) {
    static int grid_blocks = 0;
    if (grid_blocks == 0) {
        if (n_in != 20 || ws_size < WS_END) { fprintf(stderr, "kernel_launch: unexpected n_in %d / ws_size %zu\n", n_in, ws_size); grid_blocks = -1; return; }
        int dev = 0, cus = 0, per_cu = 0;
        hipGetDevice(&dev);
        hipDeviceGetAttribute(&cus, hipDeviceAttributeMultiprocessorCount, dev);
        if (hipFuncSetAttribute((const void*)hybrid_fwd, hipFuncAttributeMaxDynamicSharedMemorySize, LDS_BYTES) != hipSuccess) { fprintf(stderr, "kernel_launch: hipFuncSetAttribute failed\n"); grid_blocks = -1; return; }
        if (hipOccupancyMaxActiveBlocksPerMultiprocessor(&per_cu, (const void*)hybrid_fwd, NTHR, LDS_BYTES) != hipSuccess || per_cu < 1) { fprintf(stderr, "kernel_launch: occupancy query failed (%d)\n", per_cu); per_cu = 1; }
        (void)hipGetLastError();
        grid_blocks = cus;
        fprintf(stderr, "kernel_launch: cus %d per_cu %d grid %d\n", cus, per_cu, grid_blocks);
    }
    if (grid_blocks < 0) return;
    if (hipMemsetAsync((unsigned char*)d_ws + OFF_BAR, 0, XCD_BAR_WORDS * 4, stream) != hipSuccess) { fprintf(stderr, "kernel_launch: memset failed\n"); return; }
    Params p{};
    for (int i = 0; i < 20; ++i) p.in[i] = (const float*)d_in[i];
    p.out = (float*)d_out; p.ws = (unsigned char*)d_ws;
    void* args[] = {&p};
    hipError_t e = hipLaunchCooperativeKernel((const void*)hybrid_fwd, dim3(grid_blocks), dim3(NTHR), args, LDS_BYTES, stream);
    if (e != hipSuccess) fprintf(stderr, "kernel_launch: cooperative launch failed: %s (grid %d)\n", hipGetErrorString(e), grid_blocks);
}
```

```cpp
#include <hip/hip_runtime.h>
#include <hip/hip_cooperative_groups.h>
#include <cstdio>
#include <cstdint>
namespace cg = cooperative_groups;

typedef unsigned short bf16_t;
typedef short bf16x8 __attribute__((ext_vector_type(8)));
typedef float f32x4 __attribute__((ext_vector_type(4)));
typedef unsigned u32x4 __attribute__((ext_vector_type(4)));
typedef unsigned u32x2 __attribute__((ext_vector_type(2)));

constexpr int T_ALL = 17408, T_P = 16384, DM = 1024, NIN = 4608, DFF = 4096, INW = 4616;
constexpr int NTHR = 512;
constexpr int LDS_BYTES = 131072 + 256;
constexpr float EPS = 1e-6f;

constexpr size_t OFF_WT1 = 0;
constexpr size_t OFF_WAT = 9437184;
constexpr size_t OFF_WBT = 10485760;
constexpr size_t OFF_WOT = 11534336;
constexpr size_t OFF_WUT = 13631488;
constexpr size_t OFF_WDT = 22020096;
constexpr size_t OFF_RSTD1 = 30408704;
constexpr size_t OFF_BETA = 30478336;
constexpr size_t OFF_GL = 30756864;
constexpr size_t OFF_SSQ2 = 252198912;
constexpr size_t OFF_SSQ3 = 253313024;
constexpr size_t OFF_R1 = 33554432;
constexpr size_t OFF_WC = OFF_R1;
constexpr size_t OFF_PL = OFF_R1 + 16777216;
constexpr size_t OFF_QKV = 69206016;
constexpr size_t OFF_ZB = 122683392;
constexpr size_t OFF_PB = 140509184;
constexpr size_t OFF_U = 158334976;
constexpr size_t OFF_QN = 191889408;
constexpr size_t OFF_KT = 208666624;
constexpr size_t OFF_QK = 225443840;
constexpr size_t OFF_SC = 233832448;
constexpr size_t OFF_OA = 234373120;
constexpr size_t OFF_ORAW = OFF_QKV;
constexpr size_t OFF_HMID = OFF_QKV;
constexpr size_t OFF_PART = OFF_QKV + 142606336;
constexpr size_t OFF_BAR = 254427136;
constexpr size_t OFF_SSQP = 254427136 + 16384;
constexpr size_t OFF_SFIN = OFF_SSQP + 2097152;
constexpr size_t WS_END = OFF_SFIN + 2097152;

constexpr size_t O_Y = 0;
constexpr size_t O_CONVP = 17825792;
constexpr size_t O_POOLP = 17862656;
constexpr size_t O_SSMP = 17924096;
constexpr size_t O_CONVS = 18448384;
constexpr size_t O_POOLS = 19038208;
constexpr size_t O_SSMS = 20021248;

struct Params {
    const float* in[20];
    float* out;
    unsigned char* ws;
};

typedef __bf16 bf16x2_t_ __attribute__((ext_vector_type(2)));
typedef float f32x2_t_ __attribute__((ext_vector_type(2)));
__device__ __forceinline__ unsigned cvt_pk_bf16(float lo, float hi) { f32x2_t_ v = {lo, hi}; bf16x2_t_ b = __builtin_convertvector(v, bf16x2_t_); return __builtin_bit_cast(unsigned, b); }
__device__ __forceinline__ unsigned pk_bf16_c(float lo, float hi) { return cvt_pk_bf16(lo, hi); }
__device__ __forceinline__ bf16_t f2bf(float f) { return (bf16_t)(cvt_pk_bf16(f, 0.f) & 0xffffu); }
__device__ __forceinline__ float bf2f(bf16_t b) { return __uint_as_float(((unsigned)b) << 16); }
__device__ __forceinline__ float bflo(unsigned u) { return __uint_as_float(u << 16); }
__device__ __forceinline__ float bfhi(unsigned u) { return __uint_as_float(u & 0xffff0000u); }
__device__ __forceinline__ bf16x8 mk8(unsigned a, unsigned b, unsigned c, unsigned d) { u32x4 u = {a, b, c, d}; return __builtin_bit_cast(bf16x8, u); }
__device__ __forceinline__ float sigmoidf_(float x) { return __builtin_amdgcn_rcpf(1.0f + __expf(-x)); }
__device__ __forceinline__ float siluf_(float x) { return x * __builtin_amdgcn_rcpf(1.0f + __expf(-x)); }

#define LAS __attribute__((address_space(3)))
constexpr int BM = 256, BK = 64, HALF = 128, HTB = HALF * BK * 2;
__device__ __forceinline__ int lds_byte(int r, int c) { const int st = (r >> 4) * 2 + (c >> 5), rr = r & 15, cc = c & 31, ob = rr * 64 + cc * 2; return st * 1024 + (ob ^ (((ob >> 9) & 1) << 5)); }
__device__ __forceinline__ void stage_rc(int b, int& R, int& C) { const int st = b / 1024, sb = b % 1024, swz = sb ^ (((sb >> 9) & 1) << 5); R = (st >> 1) * 16 + swz / 64; C = (st & 1) * 32 + (swz % 64) / 2; }

__device__ __forceinline__ void unit_of(int L, int nM, int nN, int& pm, int& pn) {
    const int nwg = nM * nN; int wgid = L;
    { const int q = nwg / 8, r = nwg % 8, xcd = wgid % 8, off = wgid / 8; wgid = (xcd < r ? xcd * (q + 1) : r * (q + 1) + (xcd - r) * q) + off; }
    const int nig = 8 * nN, gid = wgid / nig, fm = gid * 8, gsz = (nM - fm) < 8 ? (nM - fm) : 8;
    pm = fm + ((wgid % nig) % gsz); pn = (wgid % nig) / gsz;
}

struct SchedStatic {
    int nM, nN, nt, G, cb;
    __device__ __forceinline__ bool get(int i, int& pm, int& pn, int& k0, int& ntu, int& set) const {
        const int L = i * G + cb; if (L >= nM * nN) return false;
        unit_of(L, nM, nN, pm, pn); k0 = 0; ntu = nt; set = 0; return true; }
};
struct SchedTwoPass {
    int nM, nN, nt, G, cb;
    __device__ __forceinline__ bool get(int i, int& pm, int& pn, int& k0, int& ntu, int& set) const {
        const int L = (i >> 1) * G + cb; if (L >= nM * nN) return false;
        unit_of(L, nM, nN, pm, pn); k0 = 0; ntu = nt; set = i & 1; return true; }
};
struct SchedStreamK {
    int pn_, ntK, per, w;
    __device__ __forceinline__ bool get(int i, int& pm, int& pn, int& k0, int& ntu, int& set) const {
        set = 0;
        if (i > 1) return false;
        const int start = w * per, p0 = start / ntK, kk = start % ntK; const int len0 = (ntK - kk) < per ? (ntK - kk) : per;
        if (i == 0) { pm = p0; k0 = kk; ntu = len0; } else { if (len0 >= per) return false; pm = p0 + 1; k0 = 0; ntu = per - len0; }
        pn = pn_; return true; }
};

template <class Epi, class Sched>
__device__ __forceinline__ void gemm_phase(const bf16_t* __restrict__ A, const bf16_t* __restrict__ Bt, const int K, const Sched& SD, const Epi& E, const bf16_t* __restrict__ A2 = nullptr, const bf16_t* __restrict__ Bt2 = nullptr) {
    extern __shared__ __attribute__((aligned(16))) unsigned char smem[];
    LAS unsigned char* lds = (LAS unsigned char*)smem;
    int tid = threadIdx.x; asm volatile("" : "+v"(tid));
    const int wid = __builtin_amdgcn_readfirstlane(tid >> 6), lane = tid & 63, wr = wid >> 2, wc = wid & 3, fr = lane & 15, fq = lane >> 4;
    unsigned voff[2], voffB[2];
#pragma unroll
    for (int i = 0; i < 2; ++i) { int R, C; stage_rc(tid * 16 + i * 8192, R, C); voff[i] = (unsigned)(R * K + C) * 2u;
        const int rho = R & 31; const int Rb = (R & ~31) + 8 * ((rho & 15) >> 2) + 4 * (rho >> 4) + (rho & 3); voffB[i] = (unsigned)(Rb * K + C) * 2u; }
    const size_t kstep = (size_t)(BK * 2);
    const size_t hstep = (size_t)HALF * K * 2;
    const size_t tstep = 2 * hstep;
    const unsigned ldsw = (unsigned)wid * 1024u;
    const int aoff = lds_byte(wr * 64 + fr, fq * 8), boff = lds_byte(wc * 32 + fr, fq * 8);
#define G_SA(b, h) (((b) * 2 + (h)) * HTB)
#define G_SB(b, h) ((4 + (b) * 2 + (h)) * HTB)
#define G_STAGE_(bufoff, gbase, vo) do { _Pragma("unroll") for (int _i = 0; _i < 2; ++_i) \
        __builtin_amdgcn_global_load_lds((const unsigned*)((const char*)(gbase) + vo[_i]), (LAS unsigned*)(lds + (bufoff) + ldsw + _i * 8192), 16, 0, 0); } while (0)
#define G_STAGE(bufoff, gbase) G_STAGE_(bufoff, gbase, voff)
#define G_STAGEB(bufoff, gbase) G_STAGE_(bufoff, gbase, voffB)
#define G_LDA(dst, b, h) do { _Pragma("unroll") for (int m = 0; m < 4; ++m) _Pragma("unroll") for (int k = 0; k < 2; ++k) dst[m][k] = *(const LAS bf16x8*)(lds + G_SA(b, h) + aoff + m * 2048 + k * 1024); } while (0)
#define G_LDB(dst, b, h) do { _Pragma("unroll") for (int n = 0; n < 2; ++n) _Pragma("unroll") for (int k = 0; k < 2; ++k) dst[n][k] = *(const LAS bf16x8*)(lds + G_SB(b, h) + boff + n * 2048 + k * 1024); } while (0)
#define G_MMA(ai, bj, Af, Bf) do { __builtin_amdgcn_s_setprio(1); _Pragma("unroll") for (int m = 0; m < 4; ++m) _Pragma("unroll") for (int n = 0; n < 2; ++n) _Pragma("unroll") for (int k = 0; k < 2; ++k) \
        acc[ai][bj][m][n] = __builtin_amdgcn_mfma_f32_16x16x32_bf16(Bf[n][k], Af[m][k], acc[ai][bj][m][n], 0, 0, 0); __builtin_amdgcn_s_setprio(0); } while (0)
#define G_WAIT_V(n) asm volatile("s_waitcnt vmcnt(" #n ")" ::: "memory")
#define G_WAIT_L(n) asm volatile("s_waitcnt lgkmcnt(" #n ")" ::: "memory")
#define G_BAR __builtin_amdgcn_s_barrier()
#define G_SCHED __builtin_amdgcn_sched_barrier(0)
    int ui = 0, pm, pn, k0, nt, set, npm = 0, npn = 0, nk0 = 0, nnt = 0, nset = 0;
    if (!SD.get(0, pm, pn, k0, nt, set)) return;
    f32x4 acc[2][2][4][2];
#pragma unroll
    for (int a = 0; a < 2; ++a)
#pragma unroll
        for (int b = 0; b < 2; ++b)
#pragma unroll
            for (int m = 0; m < 4; ++m)
#pragma unroll
                for (int n = 0; n < 2; ++n) acc[a][b][m][n] = (f32x4){0.f, 0.f, 0.f, 0.f};
    bf16x8 At[4][2], B0[2][2], B1[2][2];
    const char* cA = (const char*)(set ? A2 : A) + (size_t)pm * tstep + (size_t)k0 * kstep; const char* cB = (const char*)(set ? Bt2 : Bt) + (size_t)pn * tstep + (size_t)k0 * kstep;
    G_STAGEB(G_SB(0, 0), cB); G_STAGEB(G_SB(0, 1), cB + hstep); G_STAGE(G_SA(0, 0), cA); G_STAGE(G_SA(0, 1), cA + hstep);
    if (wr == 1) G_BAR;
    G_WAIT_V(2); G_BAR;
    G_STAGEB(G_SB(1, 0), cB + kstep); G_STAGE(G_SA(1, 0), cA + kstep); G_STAGEB(G_SB(1, 1), cB + hstep + kstep);
    G_WAIT_V(6); G_BAR;
    for (;;) {
        const bool has_next = SD.get(ui + 1, npm, npn, nk0, nnt, nset);
        const char* nA = has_next ? (const char*)(nset ? A2 : A) + (size_t)npm * tstep + (size_t)nk0 * kstep : cA; const char* nB = has_next ? (const char*)(nset ? Bt2 : Bt) + (size_t)npn * tstep + (size_t)nk0 * kstep : cB;
#pragma unroll 1
        for (int t = 0; t < nt; t += 2) {
            const bool last = (t == nt - 2);
            const char* a1 = cA + (size_t)(t + 1) * kstep;
            const char* a2 = last ? nA : cA + (size_t)(t + 2) * kstep; const char* b2 = last ? nB : cB + (size_t)(t + 2) * kstep;
            const char* a3 = a2 + kstep; const char* b3 = b2 + kstep;
            G_LDB(B0, 0, 0); G_LDB(B1, 0, 1); G_SCHED; G_LDA(At, 0, 0); G_STAGE(G_SA(1, 1), a1 + hstep);
            G_WAIT_V(8); G_WAIT_L(0); G_BAR; G_MMA(0, 0, At, B0); G_MMA(0, 1, At, B1); G_BAR; G_SCHED;
            G_LDA(At, 0, 1); G_STAGEB(G_SB(0, 0), b2); G_STAGEB(G_SB(0, 1), b2 + hstep); G_STAGE(G_SA(0, 0), a2);
            G_WAIT_V(8); G_WAIT_L(0); G_BAR; G_MMA(1, 0, At, B0); G_MMA(1, 1, At, B1); G_BAR; G_SCHED;
            G_LDB(B0, 1, 0); G_LDB(B1, 1, 1); G_SCHED; G_LDA(At, 1, 0); G_STAGE(G_SA(0, 1), a2 + hstep);
            G_WAIT_V(8); G_WAIT_L(0); G_BAR; G_MMA(0, 0, At, B0); G_MMA(0, 1, At, B1); G_BAR; G_SCHED;
            G_LDA(At, 1, 1); G_STAGEB(G_SB(1, 0), b3); G_STAGEB(G_SB(1, 1), b3 + hstep); G_STAGE(G_SA(1, 0), a3);
            G_WAIT_V(8); G_WAIT_L(0); G_BAR; G_MMA(1, 0, At, B0); G_MMA(1, 1, At, B1); G_BAR; G_SCHED;
        }
        if (wr == 0) G_BAR;
        const bool keep = E(acc, pm, pn, wr, wc, fr, fq, ui);
        if (!has_next) break;
        if (!keep)
#pragma unroll
        for (int a = 0; a < 2; ++a)
#pragma unroll
            for (int b = 0; b < 2; ++b)
#pragma unroll
                for (int m = 0; m < 4; ++m)
#pragma unroll
                    for (int n = 0; n < 2; ++n) acc[a][b][m][n] = (f32x4){0.f, 0.f, 0.f, 0.f};
        pm = npm; pn = npn; nt = nnt; cA = nA; cB = nB; ++ui;
        if (wr == 1) G_BAR;
    }
    G_WAIT_V(0);
    G_BAR;
#undef G_SA
#undef G_SB
#undef G_STAGE
#undef G_STAGEB
#undef G_STAGE_
#undef G_LDA
#undef G_LDB
#undef G_MMA
}
typedef f32x4 acc_t[2][2][4][2];
#define EPI_ROWS(body) _Pragma("unroll") for (int ai = 0; ai < 2; ++ai) _Pragma("unroll") for (int m = 0; m < 4; ++m) { const int row = pm * 256 + ai * 128 + wr * 64 + m * 16 + fr; body }
#define EPI_COLS8(body) _Pragma("unroll") for (int bj = 0; bj < 2; ++bj) { const int col = pn * 256 + bj * 128 + wc * 32 + fq * 8; const f32x4 a0 = acc[ai][bj][m][0]; const f32x4 a1 = acc[ai][bj][m][1]; body }
__device__ __forceinline__ u32x4 pack8(const f32x4& v0, const f32x4& v1) { u32x4 w; w.x = cvt_pk_bf16(v0[0], v0[1]); w.y = cvt_pk_bf16(v0[2], v0[3]); w.z = cvt_pk_bf16(v1[0], v1[1]); w.w = cvt_pk_bf16(v1[2], v1[3]); return w; }

#define XB_TMO      128
#define XB_XCNT(j)  (256  + 64 * (j))
#define XB_XSUB(j)  (1280 + 64 * (j))
#define XB_XGEN(j)  (2304 + 64 * (j))
#define XB_TOP      3328
#define XB_TOPGEN   3392
#define XCD_BAR_WORDS 3456
#define XB_SPIN_CAP (1u << 20)
__device__ __forceinline__ unsigned xb_ld(unsigned* p)              { return __hip_atomic_load(p, __ATOMIC_RELAXED, __HIP_MEMORY_SCOPE_AGENT); }
__device__ __forceinline__ unsigned xb_add(unsigned* p, unsigned v) { return __hip_atomic_fetch_add(p, v, __ATOMIC_RELAXED, __HIP_MEMORY_SCOPE_AGENT); }
__device__ __forceinline__ unsigned xb_xcc_id() { return (unsigned)__builtin_amdgcn_s_getreg((3 << 11) | 20) & 0xFu; }
#define XB_SPIN(cond, bar) do { unsigned _sp = 0; while (cond) { __builtin_amdgcn_s_sleep(1); \
    if ((++_sp & 255u) == 0u) { if (xb_ld(&(bar)[XB_TMO])) break; if (_sp > XB_SPIN_CAP) { atomicAdd(&(bar)[XB_TMO], 1u); break; } } } } while (0)
struct XcdBarrier { unsigned* bar; unsigned x; volatile LAS unsigned* st; };
__device__ __forceinline__ XcdBarrier xcd_barrier_post(unsigned* bar, volatile LAS unsigned* st) {
    XcdBarrier b; b.bar = bar; b.x = xb_xcc_id(); b.st = st;
    if (threadIdx.x == 0) (void)xb_add(&bar[XB_XCNT(b.x)], 1u);
    return b;
}
__device__ __forceinline__ void xcd_barrier_complete(unsigned* bar, unsigned x, unsigned& nloc, unsigned& nx) {
    const unsigned G = gridDim.x * gridDim.y * gridDim.z;
    unsigned sum, cnt, mine, sp = 0u;
    for (;;) {
        sum = 0u; cnt = 0u; mine = 0u;
#pragma unroll
        for (unsigned j = 0; j < 16; ++j) { const unsigned c = xb_ld(&bar[XB_XCNT(j)]); sum += c; cnt += (c > 0u) ? 1u : 0u; mine = (j == x) ? c : mine; }
        if (sum == G) break;
        __builtin_amdgcn_s_sleep(1);
        if ((++sp & 255u) == 0u) { if (xb_ld(&bar[XB_TMO])) break; if (sp > XB_SPIN_CAP) { atomicAdd(&bar[XB_TMO], 1u); break; } }
    }
    nloc = mine > 0u ? mine : 1u; nx = cnt > 0u ? cnt : 1u;
}
__device__ __forceinline__ void xcd_barrier(const XcdBarrier& b) {
    asm volatile("s_waitcnt vmcnt(0)" ::: "memory");
    __syncthreads();
    if (threadIdx.x == 0) {
        unsigned* bar = b.bar;
        __builtin_amdgcn_s_waitcnt(0);
        unsigned nloc = b.st[0], nx = b.st[1];
        if (nloc == 0u) { xcd_barrier_complete(bar, b.x, nloc, nx); b.st[0] = nloc; b.st[1] = nx; }
        const unsigned old = xb_add(&bar[XB_XSUB(b.x)], 1u);
        const unsigned gen = old / nloc;
        if (old + 1u == (gen + 1u) * nloc) {
            __builtin_amdgcn_fence(__ATOMIC_RELEASE, "agent");
            asm volatile("s_waitcnt vmcnt(0)" ::: "memory");
            const unsigned og = xb_add(&bar[XB_TOP], 1u);
            const unsigned tg = og / nx;
            if (og + 1u == (tg + 1u) * nx) xb_add(&bar[XB_TOPGEN], 1u);
            else XB_SPIN(xb_ld(&bar[XB_TOPGEN]) == tg, bar);
            __builtin_amdgcn_fence(__ATOMIC_ACQUIRE, "agent");
            xb_add(&bar[XB_XGEN(b.x)], 1u);
            asm volatile("s_waitcnt vmcnt(0)" ::: "memory");
        } else {
            XB_SPIN(xb_ld(&bar[XB_XGEN(b.x)]) == gen, bar);
            __builtin_amdgcn_fence(__ATOMIC_ACQUIRE, "agent");
            asm volatile("s_waitcnt vmcnt(0)" ::: "memory");
        }
    }
    __syncthreads();
}

__device__ void p0_transpose_tile(const float* __restrict__ src, int ldn, int K, const float* __restrict__ g, bool in_map, bf16_t* __restrict__ dst, int k0, int n0) {
    extern __shared__ __attribute__((aligned(16))) unsigned char smem[];
    float* tl = (float*)smem;
    const int tid = threadIdx.x;
    f32x4 v[8];
#pragma unroll
    for (int i = 0; i < 8; ++i) { const int idx = tid + i * NTHR; const int r = idx >> 6, c4 = (idx & 63) * 4;
        const int n = n0 + c4; const int sc = in_map ? (n < 2048 ? n : n + 8) : n;
        v[i] = __builtin_nontemporal_load((const f32x4*)(src + (size_t)(k0 + r) * ldn + sc)); }
    __syncthreads();
#pragma unroll
    for (int i = 0; i < 8; ++i) { const int idx = tid + i * NTHR; const int r = idx >> 6, c4 = (idx & 63) * 4;
        const float gs = g ? g[k0 + r] : 1.0f;
        tl[r * 257 + c4 + 0] = v[i][0] * gs; tl[r * 257 + c4 + 1] = v[i][1] * gs; tl[r * 257 + c4 + 2] = v[i][2] * gs; tl[r * 257 + c4 + 3] = v[i][3] * gs; }
    __syncthreads();
    { const int kp = (tid & 7) * 8;
#pragma unroll
      for (int ps = 0; ps < 4; ++ps) { const int n = ps * 64 + (tid >> 3); float x[8];
#pragma unroll
          for (int i = 0; i < 8; ++i) x[i] = tl[(kp + i) * 257 + n];
          u32x4 w; w.x = cvt_pk_bf16(x[0], x[1]); w.y = cvt_pk_bf16(x[2], x[3]); w.z = cvt_pk_bf16(x[4], x[5]); w.w = cvt_pk_bf16(x[6], x[7]);
          *(u32x4*)(dst + (size_t)(n0 + n) * K + k0 + kp) = w; } }
}

__device__ void p0_fold_tile(const Params& p, int ct, int ntile) {
    extern __shared__ __attribute__((aligned(16))) unsigned char smem[];
    float* Am = (float*)smem;
    float* Bm = Am + 64 * 129;
    const int tid = threadIdx.x;
    const float* wmix = p.in[10]; const float* pscale = p.in[11]; const float* wb = p.in[13];
    bf16_t* WBT = (bf16_t*)(p.ws + OFF_WBT);
    const int c0 = ct * 64, gi = c0 >> 7, cl0 = c0 & 127, n0 = ntile * 64;
    __syncthreads();
    for (int idx = tid; idx < 64 * 128; idx += NTHR) { const int c = idx >> 7, d = idx & 127; Am[c * 129 + d] = wmix[((size_t)gi * 128 + cl0 + c) * 128 + d] * pscale[gi * 128 + d]; }
    for (int idx = tid; idx < 128 * 64; idx += NTHR) { const int d = idx >> 6, n = idx & 63; Bm[d * 65 + n] = wb[(size_t)(gi * 128 + d) * 1024 + n0 + n]; }
    __syncthreads();
    const int n = tid & 63, cq = tid >> 6;
    float acc[8];
#pragma unroll
    for (int i = 0; i < 8; ++i) acc[i] = 0.f;
    for (int d = 0; d < 128; ++d) { const float bv = Bm[d * 65 + n];
#pragma unroll
        for (int i = 0; i < 8; ++i) acc[i] += Am[(cq * 8 + i) * 129 + d] * bv; }
    u32x4 w; w.x = cvt_pk_bf16(acc[0], acc[1]); w.y = cvt_pk_bf16(acc[2], acc[3]); w.z = cvt_pk_bf16(acc[4], acc[5]); w.w = cvt_pk_bf16(acc[6], acc[7]);
    *(u32x4*)(WBT + (size_t)(n0 + n) * 512 + c0 + cq * 8) = w;
}

__device__ void phase0(const Params& p) {
    extern __shared__ __attribute__((aligned(16))) unsigned char smem[];
    const int tid = threadIdx.x, G = gridDim.x;
    unsigned char* ws = p.ws;
    for (int it = blockIdx.x; it < 1024; it += G) {
        if (it < 288) { p0_transpose_tile(p.in[5], INW, 1024, p.in[15], true, (bf16_t*)(ws + OFF_WT1), (it / 18) * 64, (it % 18) * 256); }
        else if (it < 320) { const int j = it - 288; p0_transpose_tile(p.in[12], 1024, 512, nullptr, false, (bf16_t*)(ws + OFF_WAT), (j / 4) * 64, (j % 4) * 256); }
        else if (it < 384) { const int j = it - 320; p0_transpose_tile(p.in[14], 1024, 1024, nullptr, false, (bf16_t*)(ws + OFF_WOT), (j / 4) * 64, (j % 4) * 256); }
        else if (it < 640) { const int j = it - 384; p0_transpose_tile(p.in[17], 4096, 1024, p.in[16], false, (bf16_t*)(ws + OFF_WUT), (j / 16) * 64, (j % 16) * 256); }
        else if (it < 896) { const int j = it - 640; p0_transpose_tile(p.in[18], 1024, 4096, nullptr, false, (bf16_t*)(ws + OFF_WDT), (j / 4) * 64, (j % 4) * 256); }
        else { const int j = it - 896; p0_fold_tile(p, j / 16, j % 16); }
    }
    __syncthreads();
    float* WBA = (float*)smem;
    { const float* win = p.in[5]; const float* ga = p.in[15];
      for (int idx = tid; idx < 8192; idx += NTHR) { const int k = idx >> 3, j = idx & 7; WBA[j * 1024 + k] = ga[k] * win[(size_t)k * INW + 2048 + j]; } }
    __syncthreads();
    const int wave = tid >> 6, lane = tid & 63;
    bf16_t* xb = (bf16_t*)(ws + OFF_R1);
    float* rstd1 = (float*)(ws + OFF_RSTD1); float* beta = (float*)(ws + OFF_BETA); float* gl = (float*)(ws + OFF_GL);
    {
        const float mynal = -__expf(p.in[7][lane & 3]), mydtb = p.in[8][lane & 3];
        int row = blockIdx.x * 8 + wave;
        f32x4 cur[4];
        if (row < T_ALL) { const float* xr = row < T_P ? p.in[0] + (size_t)row * DM : p.in[1] + (size_t)(row - T_P) * DM;
#pragma unroll
            for (int i = 0; i < 4; ++i) cur[i] = __builtin_nontemporal_load((const f32x4*)(xr + i * 256 + lane * 4)); }
        while (row < T_ALL) {
            const int nrow = row + G * 8;
            f32x4 nxt[4];
            if (nrow < T_ALL) { const float* xr = nrow < T_P ? p.in[0] + (size_t)nrow * DM : p.in[1] + (size_t)(nrow - T_P) * DM;
#pragma unroll
                for (int i = 0; i < 4; ++i) nxt[i] = __builtin_nontemporal_load((const f32x4*)(xr + i * 256 + lane * 4)); }
            float ss = 0.f; float d[8];
#pragma unroll
            for (int j = 0; j < 8; ++j) d[j] = 0.f;
#pragma unroll
            for (int i = 0; i < 4; ++i) {
                const int col = i * 256 + lane * 4;
                const f32x4 v = cur[i];
                u32x2 w; w.x = cvt_pk_bf16(v[0], v[1]); w.y = cvt_pk_bf16(v[2], v[3]);
                *(u32x2*)(xb + (size_t)row * DM + col) = w;
                ss += (v[0] * v[0] + v[1] * v[1]) + (v[2] * v[2] + v[3] * v[3]);
#pragma unroll
                for (int j = 0; j < 8; ++j) { const f32x4 w = *(const f32x4*)(WBA + j * 1024 + col);
                    d[j] += (v[0] * w[0] + v[1] * w[1]) + (v[2] * w[2] + v[3] * w[3]); }
            }
#pragma unroll
            for (int off = 1; off < 64; off <<= 1) { ss += __shfl_xor(ss, off);
#pragma unroll
                for (int j = 0; j < 8; ++j) d[j] += __shfl_xor(d[j], off); }
            {
                const float rs = rsqrtf(ss * (1.0f / 1024.0f) + EPS);
                const int j = lane & 7;
                float dj = d[0]; dj = j == 1 ? d[1] : dj; dj = j == 2 ? d[2] : dj; dj = j == 3 ? d[3] : dj; dj = j == 4 ? d[4] : dj; dj = j == 5 ? d[5] : dj; dj = j == 6 ? d[6] : dj; dj = j == 7 ? d[7] : dj;
                const float raw = dj * rs;
                const float sg = sigmoidf_(raw);
                const float xa = raw + mydtb;
                const float ex = __expf(-fabsf(xa)); const float sp = fmaxf(xa, 0.f) + (ex < 1e-4f ? ex * (1.0f - 0.5f * ex) : __logf(1.0f + ex));
                if (lane == 0) rstd1[row] = rs;
                if (lane < 4) beta[row * 4 + lane] = sg;
                else if (lane < 8) gl[row * 4 + (lane - 4)] = mynal * sp;
            }
#pragma unroll
            for (int i = 0; i < 4; ++i) cur[i] = nxt[i];
            row = nrow;
        }
    }
    { const float* sp = p.in[3]; float* po = p.out + O_POOLS;
      for (int idx = blockIdx.x * NTHR + tid; idx < 128 * 7 * 512; idx += G * NTHR) { const int c = idx & 511, r = (idx >> 9) % 7, b = idx / (7 * 512);
          po[((size_t)b * 15 + r) * 512 + c] = sp[((size_t)b * 15 + 8 + r) * 512 + c]; } }
}

struct EpiP1 {
    const float* rstd1; bf16_t* qkv; bf16_t* zb; bf16_t* pb; bf16_t* sga; bf16_t* sgb; float* out;
    __device__ __forceinline__ bool operator()(acc_t& acc, int pm, int pn, int wr, int wc, int fr, int fq, int ui) const {
        EPI_ROWS(
            const float rs = rstd1[row];
            const bool isS = row >= T_P; int b; int t;
            if (!isS) { b = row >> 11; t = row & 2047; } else { const int r2 = row - T_P; b = r2 >> 3; t = r2 & 7; }
            EPI_COLS8(
                const f32x4 v0 = a0 * rs; const f32x4 v1 = a1 * rs;
                if (pn < 6) {
                    *(u32x4*)(qkv + (size_t)row * 1536 + col) = pack8(v0, v1);
                    const int cst = isS ? t - 5 : t - 2045;
                    if (cst >= 0) { float* dst = out + (isS ? O_CONVS : O_CONVP) + ((size_t)b * 3 + cst) * 1536 + col; *(f32x4*)dst = v0; *(f32x4*)(dst + 4) = v1; }
                } else if (pn < 8) {
                    *(u32x4*)(zb + (size_t)row * 512 + (col - 1536)) = pack8(v0, v1);
                } else if (pn < 10) {
                    const int c = col - 2048;
                    *(u32x4*)(pb + (size_t)row * 512 + c) = pack8(v0, v1);
                    if (isS) { float* dst = out + O_POOLS + ((size_t)b * 15 + 7 + t) * 512 + c; *(f32x4*)dst = v0; *(f32x4*)(dst + 4) = v1; }
                    else if (t >= 2033) { float* dst = out + O_POOLP + ((size_t)b * 15 + (t - 2033)) * 512 + c; *(f32x4*)dst = v0; *(f32x4*)(dst + 4) = v1; }
                } else {
                    f32x4 s0; f32x4 s1; const float kk_ = rs * -1.4426950408889634f;
                    s0[0] = __builtin_amdgcn_rcpf(1.0f + __builtin_amdgcn_exp2f(a0[0] * kk_)); s0[1] = __builtin_amdgcn_rcpf(1.0f + __builtin_amdgcn_exp2f(a0[1] * kk_));
                    s0[2] = __builtin_amdgcn_rcpf(1.0f + __builtin_amdgcn_exp2f(a0[2] * kk_)); s0[3] = __builtin_amdgcn_rcpf(1.0f + __builtin_amdgcn_exp2f(a0[3] * kk_));
                    s1[0] = __builtin_amdgcn_rcpf(1.0f + __builtin_amdgcn_exp2f(a1[0] * kk_)); s1[1] = __builtin_amdgcn_rcpf(1.0f + __builtin_amdgcn_exp2f(a1[1] * kk_));
                    s1[2] = __builtin_amdgcn_rcpf(1.0f + __builtin_amdgcn_exp2f(a1[2] * kk_)); s1[3] = __builtin_amdgcn_rcpf(1.0f + __builtin_amdgcn_exp2f(a1[3] * kk_));
                    bf16_t* dst = pn < 14 ? sga + (size_t)row * 1024 + (col - 2560) : sgb + (size_t)row * 1024 + (col - 3584);
                    *(u32x4*)dst = pack8(s0, s1);
                }
            )
        )
        return false;
    }
};
__device__ void phase1(const Params& p) {
    unsigned char* ws = p.ws;
    bf16_t* sga = (bf16_t*)(p.out + O_Y);
    EpiP1 E{(const float*)(ws + OFF_RSTD1), (bf16_t*)(ws + OFF_QKV), (bf16_t*)(ws + OFF_ZB), (bf16_t*)(ws + OFF_PB), sga, sga + (size_t)T_ALL * 1024, p.out};
    SchedStatic SD{T_ALL / 256, NIN / 256, 1024 / 64, (int)gridDim.x, (int)blockIdx.x};
    gemm_phase<EpiP1, SchedStatic>((const bf16_t*)(ws + OFF_R1), (const bf16_t*)(ws + OFF_WT1), 1024, SD, E);
}

__device__ __forceinline__ int fragoff(int r, int c, int nk) { return (((r >> 4) * nk + (c >> 5)) * 64 + ((c & 31) >> 3) * 16 + (r & 15)) * 8 + (c & 7); }
__device__ __forceinline__ void prep_load_raw(const Params& p, int item, bf16_t (&r)[67]) {
    const int tid = threadIdx.x;
    if (tid < 384) {
        const int h = item & 3, bc = item >> 2, c = bc & 31, b = bc >> 5, row0 = b * 2048 + c * 64;
        const int which = tid >> 7, cc = tid & 127, col = which * 512 + h * 128 + cc;
        const bf16_t* src = (const bf16_t*)(p.ws + OFF_QKV) + (size_t)row0 * 1536 + col;
#pragma unroll
        for (int i = 0; i < 3; ++i) r[i] = 0;
        if (c > 0) {
#pragma unroll
            for (int i = 0; i < 3; ++i) r[i] = src[(i - 3) * 1536]; }
#pragma unroll
        for (int t = 0; t < 64; ++t) r[3 + t] = src[t * 1536];
    }
}
__device__ __forceinline__ void prep_item(const Params& p, int item, bf16_t (&r)[67], int next_item) {
    extern __shared__ __attribute__((aligned(16))) unsigned char smem[];
    float* L = (float*)smem;
    float* CQ = L; float* CK = L + 8448; float* CV = L + 16896; float* MM = L + 25344; float* GC = MM + 4096; float* BE = GC + 64; float* EG = BE + 64;
    const int tid = threadIdx.x, lane = tid & 63, wave = tid >> 6, fr = lane & 15, fq = lane >> 4;
    unsigned char* ws = p.ws;
    const bf16_t* qkv = (const bf16_t*)(ws + OFF_QKV);
    const float* betab = (const float*)(ws + OFF_BETA); const float* glb = (const float*)(ws + OFF_GL);
    float* U = (float*)(ws + OFF_U); bf16_t* WC = (bf16_t*)(ws + OFF_WC); bf16_t* QN = (bf16_t*)(ws + OFF_QN); bf16_t* KT = (bf16_t*)(ws + OFF_KT);
    bf16_t* QK = (bf16_t*)(ws + OFF_QK); float* SC = (float*)(ws + OFF_SC);
    const int h = item & 3, bc = item >> 2, c = bc & 31, b = bc >> 5; const int row0 = b * 2048 + c * 64;
    __syncthreads();
    if (tid < 384) {
        const int which = tid >> 7, cc = tid & 127, col = which * 512 + h * 128 + cc;
        const float* wcv = p.in[6];
        const float w0 = wcv[col], w1 = wcv[1536 + col], w2 = wcv[3072 + col], w3 = wcv[4608 + col];
        float* dst = L + which * 8448 + cc;
#pragma unroll
        for (int t = 0; t < 64; ++t) {
            const float y = w0 * bf2f(r[t]) + w1 * bf2f(r[t + 1]) + w2 * bf2f(r[t + 2]) + w3 * bf2f(r[t + 3]);
            dst[t * 132] = siluf_(y);
        }
        if (next_item < 1024) prep_load_raw(p, next_item, r);
    } else if (tid < 448) {
        const int t = tid - 384;
        float g = glb[(size_t)(row0 + t) * 4 + h]; const float be = betab[(size_t)(row0 + t) * 4 + h];
#pragma unroll
        for (int off = 1; off < 64; off <<= 1) { const float v = __shfl_up(g, off); if (lane >= off) g += v; }
        GC[t] = g; BE[t] = be; EG[t] = __expf(g);
    }
    __syncthreads();
    { const int rid = tid >> 2, part = tid & 3; float* src = L + (rid >> 6) * 8448 + (rid & 63) * 132 + part * 32;
      f32x4 v[8]; float ss = 0.f;
#pragma unroll
      for (int i = 0; i < 8; ++i) { v[i] = *(const f32x4*)(src + i * 4); ss += v[i][0] * v[i][0] + v[i][1] * v[i][1] + v[i][2] * v[i][2] + v[i][3] * v[i][3]; }
      ss += __shfl_xor(ss, 1); ss += __shfl_xor(ss, 2);
      const float sc = rsqrtf(ss + EPS) * (rid < 64 ? 0.08838834764831845f : 1.0f);
#pragma unroll
      for (int i = 0; i < 8; ++i) *(f32x4*)(src + i * 4) = v[i] * sc; }
    __syncthreads();
    for (int x = wave; x < 20; x += 8) {
        const bool iskk = x < 10; const int xx = iskk ? x : x - 10;
        const int ti = xx < 1 ? 0 : (xx < 3 ? 1 : (xx < 6 ? 2 : 3)); const int tj = xx - ti * (ti + 1) / 2;
        const float* Ap = (iskk ? CK : CQ) + (ti * 16 + fr) * 132 + fq * 4; const float* Bp = CK + (tj * 16 + fr) * 132 + fq * 4;
        f32x4 a4 = {0.f, 0.f, 0.f, 0.f};
#pragma unroll
        for (int k0 = 0; k0 < 128; k0 += 16) {
            const f32x4 av = *(const f32x4*)(Ap + k0), bv = *(const f32x4*)(Bp + k0);
            a4 = __builtin_amdgcn_mfma_f32_16x16x4f32(av[0], bv[0], a4, 0, 0, 0);
            a4 = __builtin_amdgcn_mfma_f32_16x16x4f32(av[1], bv[1], a4, 0, 0, 0);
            a4 = __builtin_amdgcn_mfma_f32_16x16x4f32(av[2], bv[2], a4, 0, 0, 0);
            a4 = __builtin_amdgcn_mfma_f32_16x16x4f32(av[3], bv[3], a4, 0, 0, 0);
        }
#pragma unroll
        for (int j = 0; j < 4; ++j) {
            const int i = ti * 16 + fq * 4 + j, jj = tj * 16 + fr;
            const float v = a4[j] * __expf(fminf(GC[i] - GC[jj], 0.f));
            if (iskk) MM[i * 64 + jj] = (i > jj) ? v * BE[i] : 0.f;
            else QK[(size_t)item * 4096 + fragoff(i, jj, 2)] = f2bf((i >= jj) ? v : 0.f);
        }
    }
    for (int idx = tid; idx < 1536; idx += NTHR) {
        const int u = idx >> 8; const int ti = u < 3 ? 0 : (u < 5 ? 1 : 2); const int tj = u < 3 ? u + 1 : (u < 5 ? u - 1 : 3);
        const int r = (idx & 255) >> 4, ci = idx & 15;
        QK[(size_t)item * 4096 + fragoff(ti * 16 + r, tj * 16 + ci, 2)] = 0;
    }
    { const int t = tid >> 3, d0 = (tid & 7) * 16; const float* src = CQ + t * 132 + d0;
      const f32x4 a = *(const f32x4*)src, b4 = *(const f32x4*)(src + 4), c4 = *(const f32x4*)(src + 8), d4 = *(const f32x4*)(src + 12);
      u32x4 w0, w1; w0.x = cvt_pk_bf16(a[0], a[1]); w0.y = cvt_pk_bf16(a[2], a[3]); w0.z = cvt_pk_bf16(b4[0], b4[1]); w0.w = cvt_pk_bf16(b4[2], b4[3]);
      w1.x = cvt_pk_bf16(c4[0], c4[1]); w1.y = cvt_pk_bf16(c4[2], c4[3]); w1.z = cvt_pk_bf16(d4[0], d4[1]); w1.w = cvt_pk_bf16(d4[2], d4[3]);
      bf16_t* dst = QN + (size_t)item * 8192; *(u32x4*)(dst + fragoff(t, d0, 4)) = w0; *(u32x4*)(dst + fragoff(t, d0 + 8, 4)) = w1; }
    { const int d = tid >> 2, t0 = (tid & 3) * 16; float v[16];
#pragma unroll
      for (int i = 0; i < 16; ++i) v[i] = CK[(t0 + i) * 132 + d];
      u32x4 w0, w1; w0.x = cvt_pk_bf16(v[0], v[1]); w0.y = cvt_pk_bf16(v[2], v[3]); w0.z = cvt_pk_bf16(v[4], v[5]); w0.w = cvt_pk_bf16(v[6], v[7]);
      w1.x = cvt_pk_bf16(v[8], v[9]); w1.y = cvt_pk_bf16(v[10], v[11]); w1.z = cvt_pk_bf16(v[12], v[13]); w1.w = cvt_pk_bf16(v[14], v[15]);
      bf16_t* dst = KT + (size_t)item * 8192; *(u32x4*)(dst + fragoff(d, t0, 2)) = w0; *(u32x4*)(dst + fragoff(d, t0 + 8, 2)) = w1; }
    if (tid < 64) { SC[(size_t)item * 132 + tid] = EG[tid]; SC[(size_t)item * 132 + 64 + tid] = __expf(GC[63] - GC[tid]); if (tid == 0) SC[(size_t)item * 132 + 128] = EG[63]; }
    __syncthreads();
    for (int idx = tid; idx < 64 * 128; idx += NTHR) { const int i = idx >> 7, cc = idx & 127; const float be = BE[i]; CV[i * 132 + cc] *= be; CK[i * 132 + cc] *= be * EG[i]; }
    __syncthreads();
#pragma unroll 1
    for (int ib = 0; ib < 4; ++ib) {
        if (ib > 0) {
#pragma unroll 1
            for (int q = 0; q < 2; ++q) {
                const int ntile = wave * 2 + q; float* Rb = (ntile < 8 ? CV : CK) + (ntile & 7) * 16;
                f32x4 a4;
#pragma unroll
                for (int j = 0; j < 4; ++j) a4[j] = Rb[(ib * 16 + fq * 4 + j) * 132 + fr];
#pragma unroll 1
                for (int jb = 0; jb < ib; ++jb) {
#pragma unroll
                    for (int ks = 0; ks < 4; ++ks) {
                        const float av = -MM[(ib * 16 + fr) * 64 + jb * 16 + ks * 4 + fq];
                        const float bv = Rb[(jb * 16 + ks * 4 + fq) * 132 + fr];
                        a4 = __builtin_amdgcn_mfma_f32_16x16x4f32(av, bv, a4, 0, 0, 0);
                    }
                }
#pragma unroll
                for (int j = 0; j < 4; ++j) Rb[(ib * 16 + fq * 4 + j) * 132 + fr] = a4[j];
            }
            __syncthreads();
        }
        if (tid < 256) {
            float* Rb = (tid < 128 ? CV : CK) + (tid & 127) + ib * 16 * 132; const float* Mb = MM + (ib * 16) * 64 + ib * 16;
            float x[16];
#pragma unroll
            for (int i = 0; i < 16; ++i) {
                float a = Rb[i * 132];
#pragma unroll
                for (int j = 0; j < i; ++j) a -= Mb[i * 64 + j] * x[j];
                x[i] = a;
            }
#pragma unroll
            for (int i = 0; i < 16; ++i) Rb[i * 132] = x[i];
        }
        __syncthreads();
    }
#pragma unroll
    for (int k = 0; k < 4; ++k) { const int idx = tid + k * NTHR; const int i = idx >> 5, c4 = (idx & 31) * 4;
        const f32x4 uv = *(const f32x4*)(CV + i * 132 + c4); *(f32x4*)(U + (size_t)item * 8192 + i * 128 + c4) = uv;
        const f32x4 wv = *(const f32x4*)(CK + i * 132 + c4); u32x2 w; w.x = cvt_pk_bf16(wv[0], wv[1]); w.y = cvt_pk_bf16(wv[2], wv[3]);
        *(u32x2*)(WC + (size_t)item * 8192 + fragoff(i, c4, 4)) = w; }
}

__device__ void phase2(const Params& p) {
    bf16_t r[67];
    if ((int)blockIdx.x < 1024) prep_load_raw(p, blockIdx.x, r);
    for (int item = blockIdx.x; item < 1024; item += gridDim.x) prep_item(p, item, r, item + (int)gridDim.x);
}

constexpr int SL_SB = 0, SL_VN = 4352, SL_VS = 6656;
struct ScanRegs { bf16x8 a4[4]; bf16x8 aK[2]; bf16x8 aX[2]; f32x4 x4; f32x4 u4; float last; };
struct ScanPtrs { const char* pA; const char* pK; const char* pQ; const char* pU; const char* pS; int next; int rowoff; };
__device__ __forceinline__ void scan_load(ScanRegs& R, ScanPtrs& P, int role) {
#pragma unroll
    for (int ks = 0; ks < 4; ++ks) R.a4[ks] = *(const bf16x8*)(P.pA + ks * 1024);
    R.aK[0] = *(const bf16x8*)(P.pK); R.aK[1] = *(const bf16x8*)(P.pK + 1024);
    R.x4 = *(const f32x4*)(P.pS + (role ? 0 : 256));
    R.last = *(const float*)(P.pS + 512 - P.rowoff);
    R.aX[0] = *(const bf16x8*)(P.pQ); R.aX[1] = *(const bf16x8*)(P.pQ + 1024);
    R.u4[0] = *(const float*)(P.pU); R.u4[1] = *(const float*)(P.pU + 512); R.u4[2] = *(const float*)(P.pU + 1024); R.u4[3] = *(const float*)(P.pU + 1536);
    const bool adv = P.next < 31;
    P.pA += adv ? 65536 : 0; P.pK += adv ? 65536 : 0; P.pQ += adv ? 32768 : 0; P.pU += adv ? 131072 : 0; P.pS += adv ? 2112 : 0; P.next += adv ? 1 : 0;
}
__device__ __forceinline__ void scan_chunk(const ScanRegs& R, f32x4& S, float*& pO, LAS unsigned char* lds, int role, int mt, int wave, int fr, int fq) {
    f32x4 acc = {0.f, 0.f, 0.f, 0.f};
#pragma unroll
    for (int ks = 0; ks < 4; ++ks) { const bf16x8 sb = *(const LAS bf16x8*)(lds + SL_SB + fr * 272 + (ks * 32 + fq * 8) * 2);
        acc = __builtin_amdgcn_mfma_f32_16x16x32_bf16(R.a4[ks], sb, acc, 0, 0, 0); }
    if (!role) {
        float vn[4], vs[4];
#pragma unroll
        for (int j = 0; j < 4; ++j) { vn[j] = R.u4[j] - acc[j]; vs[j] = vn[j] * R.x4[j]; }
        u32x2 wn_, ws_; wn_.x = cvt_pk_bf16(vn[0], vn[1]); wn_.y = cvt_pk_bf16(vn[2], vn[3]); ws_.x = cvt_pk_bf16(vs[0], vs[1]); ws_.y = cvt_pk_bf16(vs[2], vs[3]);
        *(LAS u32x2*)(lds + SL_VN + (fr * 72 + mt * 16 + fq * 4) * 2) = wn_;
        *(LAS u32x2*)(lds + SL_VS + (fr * 72 + mt * 16 + fq * 4) * 2) = ws_;
    } else {
#pragma unroll
        for (int j = 0; j < 4; ++j) acc[j] *= R.x4[j];
    }
    __syncthreads();
    {
        const bf16x8 v0 = *(const LAS bf16x8*)(lds + SL_VS + fr * 144 + (fq * 8) * 2), v1 = *(const LAS bf16x8*)(lds + SL_VS + fr * 144 + (32 + fq * 8) * 2);
        S = S * R.last;
        S = __builtin_amdgcn_mfma_f32_16x16x32_bf16(R.aK[0], v0, S, 0, 0, 0);
        S = __builtin_amdgcn_mfma_f32_16x16x32_bf16(R.aK[1], v1, S, 0, 0, 0);
        u32x2 w; w.x = pk_bf16_c(S[0], S[1]); w.y = pk_bf16_c(S[2], S[3]);
        *(LAS u32x2*)(lds + SL_SB + (fr * 136 + wave * 16 + fq * 4) * 2) = w;
    }
    if (role) {
        const bf16x8 n0 = *(const LAS bf16x8*)(lds + SL_VN + fr * 144 + (fq * 8) * 2), n1 = *(const LAS bf16x8*)(lds + SL_VN + fr * 144 + (32 + fq * 8) * 2);
        acc = __builtin_amdgcn_mfma_f32_16x16x32_bf16(R.aX[0], n0, acc, 0, 0, 0);
        acc = __builtin_amdgcn_mfma_f32_16x16x32_bf16(R.aX[1], n1, acc, 0, 0, 0);
        pO[0] = acc[0]; pO[16] = acc[1]; pO[32] = acc[2]; pO[48] = acc[3];
    }
    pO += 32768;
    __syncthreads();
}
__device__ void scan_slice(const Params& p, int wi) {
    extern __shared__ __attribute__((aligned(16))) unsigned char smem[];
    LAS unsigned char* lds = (LAS unsigned char*)smem;
    const int tid = threadIdx.x, lane = tid & 63, wave = __builtin_amdgcn_readfirstlane(tid >> 6), fr = lane & 15, fq = lane >> 4;
    const int seq = wi >> 3, slice = wi & 7, b = seq >> 2, h = seq & 3, e0 = slice * 16, role = wave >> 2, mt = wave & 3;
    unsigned char* ws = p.ws;
    __syncthreads();
    for (int i = tid; i < 4352 / 4; i += NTHR) *(LAS unsigned*)(lds + SL_SB + i * 4) = 0u;
    f32x4 S = {0.f, 0.f, 0.f, 0.f};
    const size_t item0 = (size_t)((b * 32) * 4 + h);
    ScanPtrs P;
    P.pA = (const char*)((role ? (const bf16_t*)(ws + OFF_QN) : (const bf16_t*)(ws + OFF_WC)) + item0 * 8192 + (mt * 4) * 512 + lane * 8);
    P.pK = (const char*)((const bf16_t*)(ws + OFF_KT) + item0 * 8192 + (wave * 2) * 512 + lane * 8);
    P.pQ = (const char*)((const bf16_t*)(ws + OFF_QK) + item0 * 4096 + (mt * 2) * 512 + lane * 8);
    P.pU = (const char*)((const float*)(ws + OFF_U) + item0 * 8192 + (mt * 16 + fq * 4) * 128 + e0 + fr);
    P.pS = (const char*)((const float*)(ws + OFF_SC) + item0 * 132 + mt * 16 + fq * 4);
    P.next = 0; P.rowoff = (mt * 16 + fq * 4) * 4;
    float* pO = (float*)(ws + OFF_ORAW) + ((item0 * 8 + slice) * 64 + mt * 16 + fq * 4) * 16 + fr;
    ScanRegs R0, R1;
    scan_load(R0, P, role); scan_load(R1, P, role);
    __syncthreads();
#pragma unroll 1
    for (int c = 0; c < 32; c += 2) {
        scan_chunk(R0, S, pO, lds, role, mt, wave, fr, fq); scan_load(R0, P, role);
        scan_chunk(R1, S, pO, lds, role, mt, wave, fr, fq); scan_load(R1, P, role);
    }
    float* So = (float*)(p.ws + OFF_SFIN) + (size_t)wi * 2048 + (wave * 16 + fq * 4) * 16 + fr;
    So[0] = S[0]; So[16] = S[1]; So[32] = S[2]; So[48] = S[3];
}

__device__ void phase3b(const Params& p) {
    unsigned char* ws = p.ws;
    const float* OR = (const float*)(ws + OFF_ORAW); const float* SSQP = (const float*)(ws + OFF_SSQP);
    const bf16_t* zb = (const bf16_t*)(ws + OFF_ZB); bf16_t* OA = (bf16_t*)(ws + OFF_OA); const float* wn = p.in[9];
    {
        const int wv = threadIdx.x >> 6, ln = threadIdx.x & 63;
        for (int row = blockIdx.x * 8 + wv; row < T_P; row += gridDim.x * 8) {
            const int c8 = ln * 8, h = c8 >> 7, e = c8 & 127;
            const int bb = row >> 11, t = row & 2047; const size_t item = (size_t)((bb * 32 + (t >> 6)) * 4 + h);
            const float* src = OR + ((item * 8 + (e >> 4)) * 64 + (t & 63)) * 16 + (e & 15);
            const f32x4 o0 = *(const f32x4*)src, o1 = *(const f32x4*)(src + 4);
            float ss = (o0[0] * o0[0] + o0[1] * o0[1]) + (o0[2] * o0[2] + o0[3] * o0[3]) + (o1[0] * o1[0] + o1[1] * o1[1]) + (o1[2] * o1[2] + o1[3] * o1[3]);
            ss += __shfl_xor(ss, 1); ss += __shfl_xor(ss, 2); ss += __shfl_xor(ss, 4); ss += __shfl_xor(ss, 8);
            const float rs = rsqrtf(ss * (1.0f / 128.0f) + EPS);
            const u32x4 z = *(const u32x4*)(zb + (size_t)row * 512 + c8);
            const f32x4 w0 = *(const f32x4*)(wn + e), w1 = *(const f32x4*)(wn + e + 4);
            u32x4 w; w.x = cvt_pk_bf16(o0[0] * rs * w0[0] * siluf_(bflo(z.x)), o0[1] * rs * w0[1] * siluf_(bfhi(z.x)));
            w.y = cvt_pk_bf16(o0[2] * rs * w0[2] * siluf_(bflo(z.y)), o0[3] * rs * w0[3] * siluf_(bfhi(z.y)));
            w.z = cvt_pk_bf16(o1[0] * rs * w1[0] * siluf_(bflo(z.z)), o1[1] * rs * w1[1] * siluf_(bfhi(z.z)));
            w.w = cvt_pk_bf16(o1[2] * rs * w1[2] * siluf_(bflo(z.w)), o1[3] * rs * w1[3] * siluf_(bfhi(z.w)));
            *(u32x4*)(OA + (size_t)row * 512 + c8) = w;
        }
        (void)SSQP;
    }
    { const float* SF = (const float*)(ws + OFF_SFIN); float* So = p.out + O_SSMP;
      for (int idx = blockIdx.x * NTHR + threadIdx.x; idx < 32 * 128 * 32; idx += gridDim.x * NTHR) {
          const int e4 = (idx & 31) * 4, dk = (idx >> 5) & 127, seq = idx >> 12;
          *(f32x4*)(So + (size_t)seq * 16384 + dk * 128 + e4) = *(const f32x4*)(SF + (size_t)(seq * 8 + (e4 >> 4)) * 2048 + dk * 16 + (e4 & 15)); } }
}

__device__ void sample_item(const Params& p, int it) {
    extern __shared__ __attribute__((aligned(16))) unsigned char smem[];
    float* L = (float*)smem;
    float* CQ = L; float* CK = L + 1024; float* CV = L + 2048; float* A8 = L + 3072; float* B8 = L + 3080; float* KQ = L + 3088; float* RED = L + 3104; float* OL = L + 4128;
    const int tid = threadIdx.x, lane = tid & 63, wave = tid >> 6;
    unsigned char* ws = p.ws;
    const bf16_t* qkv = (const bf16_t*)(ws + OFF_QKV); const bf16_t* zb = (const bf16_t*)(ws + OFF_ZB); bf16_t* OA = (bf16_t*)(ws + OFF_OA);
    const float* betab = (const float*)(ws + OFF_BETA); const float* glb = (const float*)(ws + OFF_GL);
    const int b = it >> 2, h = it & 3, row0 = T_P + b * 8;
    const int e = tid & 127, qd = tid >> 7;
    float S[32];
    { const float* s0p = p.in[4] + ((size_t)(b * 4 + h) * 128 + qd * 32) * 128 + e;
#pragma unroll
      for (int i = 0; i < 32; ++i) S[i] = s0p[i * 128]; }
    __syncthreads();
    if (tid < 384) {
        const int which = tid >> 7, cc = tid & 127, col = which * 512 + h * 128 + cc;
        const float* wcv = p.in[6]; const float* sc = p.in[2];
        const float w0 = wcv[col], w1 = wcv[1536 + col], w2 = wcv[3072 + col], w3 = wcv[4608 + col];
        float r0 = sc[((size_t)b * 3 + 0) * 1536 + col], r1 = sc[((size_t)b * 3 + 1) * 1536 + col], r2 = sc[((size_t)b * 3 + 2) * 1536 + col];
        float* dst = L + which * 1024 + cc;
#pragma unroll
        for (int t = 0; t < 8; ++t) {
            const float r3 = bf2f(qkv[(size_t)(row0 + t) * 1536 + col]);
            const float y = w0 * r0 + w1 * r1 + w2 * r2 + w3 * r3;
            dst[t * 128] = siluf_(y);
            r0 = r1; r1 = r2; r2 = r3;
        }
    } else if (tid < 392) {
        const int t = tid - 384;
        A8[t] = __expf(glb[(size_t)(row0 + t) * 4 + h]); B8[t] = betab[(size_t)(row0 + t) * 4 + h];
    }
    __syncthreads();
    { const int rid = tid >> 5, part = tid & 31; float* src = L + (rid >> 3) * 1024 + (rid & 7) * 128 + part * 4;
      f32x4 v = *(const f32x4*)src; float ss = v[0] * v[0] + v[1] * v[1] + v[2] * v[2] + v[3] * v[3];
      ss += __shfl_xor(ss, 1); ss += __shfl_xor(ss, 2); ss += __shfl_xor(ss, 4); ss += __shfl_xor(ss, 8); ss += __shfl_xor(ss, 16);
      const float sc = rsqrtf(ss + EPS) * (rid < 8 ? 0.08838834764831845f : 1.0f);
      *(f32x4*)src = v * sc; }
    __syncthreads();
    { const int t = wave; float kq = CK[t * 128 + lane] * CQ[t * 128 + lane] + CK[t * 128 + 64 + lane] * CQ[t * 128 + 64 + lane];
#pragma unroll
      for (int off = 1; off < 64; off <<= 1) kq += __shfl_xor(kq, off);
      if (lane == 0) KQ[t] = kq; }
    __syncthreads();
#pragma unroll 1
    for (int t = 0; t < 8; ++t) {
        float r = 0.f, pp = 0.f;
#pragma unroll
        for (int i = 0; i < 32; ++i) { r += CK[t * 128 + qd * 32 + i] * S[i]; pp += CQ[t * 128 + qd * 32 + i] * S[i]; }
        RED[(qd * 128 + e) * 2] = r; RED[(qd * 128 + e) * 2 + 1] = pp;
        __syncthreads();
        r = (RED[e * 2] + RED[(128 + e) * 2]) + (RED[(256 + e) * 2] + RED[(384 + e) * 2]);
        pp = (RED[e * 2 + 1] + RED[(128 + e) * 2 + 1]) + (RED[(256 + e) * 2 + 1] + RED[(384 + e) * 2 + 1]);
        const float a = A8[t], be = B8[t];
        const float delta = be * (CV[t * 128 + e] - a * r);
        const float o = a * pp + KQ[t] * delta;
#pragma unroll
        for (int i = 0; i < 32; ++i) S[i] = a * S[i] + CK[t * 128 + qd * 32 + i] * delta;
        if (qd == 0) OL[t * 128 + e] = o;
        __syncthreads();
    }
    { float* so = p.out + O_SSMS + ((size_t)(b * 4 + h) * 128 + qd * 32) * 128 + e;
#pragma unroll
      for (int i = 0; i < 32; ++i) so[i * 128] = S[i]; }
    { const int t = wave; const float o0 = OL[t * 128 + lane], o1 = OL[t * 128 + 64 + lane]; float ss = o0 * o0 + o1 * o1;
#pragma unroll
      for (int off = 1; off < 64; off <<= 1) ss += __shfl_xor(ss, off);
      const float rs = rsqrtf(ss * (1.0f / 128.0f) + EPS);
      const float z0 = bf2f(zb[(size_t)(row0 + t) * 512 + h * 128 + lane]), z1 = bf2f(zb[(size_t)(row0 + t) * 512 + h * 128 + 64 + lane]);
      OA[(size_t)(row0 + t) * 512 + h * 128 + lane] = f2bf(o0 * rs * p.in[9][lane] * siluf_(z0));
      OA[(size_t)(row0 + t) * 512 + h * 128 + 64 + lane] = f2bf(o1 * rs * p.in[9][64 + lane] * siluf_(z1)); }
}

template <int WIN, int NR>
__device__ __forceinline__ void pool_seq(const bf16_t* __restrict__ pb, bf16_t* __restrict__ PL, const float* __restrict__ sp, int base, int t0, int b, bool isS, int col) {
    float v[NR + WIN - 1];
#pragma unroll
    for (int i = 0; i < NR + WIN - 1; ++i) { const int t = t0 - (WIN - 1) + i;
        float x = 0.f;
        if (t >= 0) x = bf2f(pb[(size_t)(base + t) * 512 + col]);
        else if (isS) x = sp[((size_t)b * 15 + 15 + t) * 512 + col];
        v[i] = x; }
    float sum = 0.f;
#pragma unroll
    for (int s2 = 0; s2 < WIN - 1; ++s2) sum += v[s2];
#pragma unroll
    for (int r = 0; r < NR; ++r) { const int t = t0 + r;
        sum += v[r + WIN - 1];
        const int cnt = isS ? WIN : (t + 1 < WIN ? t + 1 : WIN);
        PL[(size_t)(base + t) * 512 + col] = f2bf(sum * __builtin_amdgcn_rcpf((float)cnt) - v[r + WIN - 1]);
        sum -= v[r]; }
}
__device__ void pool_item(const Params& p, int pt) {
    const int col = threadIdx.x, gi = col >> 7;
    const bf16_t* pb = (const bf16_t*)(p.ws + OFF_PB); bf16_t* PL = (bf16_t*)(p.ws + OFF_PL);
    const float* sp = p.in[3];
    if (pt < 256) {
        const int b = pt >> 5, t0 = (pt & 31) * 64, base = b * 2048;
        if (gi == 0) pool_seq<2, 64>(pb, PL, sp, base, t0, b, false, col);
        else if (gi == 1) pool_seq<4, 64>(pb, PL, sp, base, t0, b, false, col);
        else if (gi == 2) pool_seq<8, 64>(pb, PL, sp, base, t0, b, false, col);
        else pool_seq<16, 64>(pb, PL, sp, base, t0, b, false, col);
    } else {
#pragma unroll 1
        for (int q = 0; q < 8; ++q) { const int b = (pt - 256) * 8 + q, base = T_P + b * 8;
            if (gi == 0) pool_seq<2, 8>(pb, PL, sp, base, 0, b, true, col);
            else if (gi == 1) pool_seq<4, 8>(pb, PL, sp, base, 0, b, true, col);
            else if (gi == 2) pool_seq<8, 8>(pb, PL, sp, base, 0, b, true, col);
            else pool_seq<16, 8>(pb, PL, sp, base, 0, b, true, col); }
    }
}

__device__ void phase3(const Params& p) {
    if (gridDim.x == 256) {
        const int cb = blockIdx.x, xcd = cb & 7, q = cb >> 3;
        scan_slice(p, (xcd * 4 + (q >> 3)) * 8 + (q & 7));
    } else {
        for (int wi = blockIdx.x; wi < 256; wi += gridDim.x) scan_slice(p, wi);
    }
    for (int it = blockIdx.x; it < 784; it += gridDim.x) { if (it < 512) sample_item(p, it); else pool_item(p, it - 512); }
}

struct EpiP4 {
    const bf16_t* sga; const bf16_t* sgb; bf16_t* MG;
    __device__ __forceinline__ bool operator()(acc_t& acc, int pm, int pn, int wr, int wc, int fr, int fq, int ui) const {
        if ((ui & 1) == 0) {
            EPI_ROWS(
                _Pragma("unroll") for (int bj = 0; bj < 2; ++bj) { const int col = pn * 256 + bj * 128 + wc * 32 + fq * 8;
                    const u32x4 ga = *(const u32x4*)(sga + (size_t)row * 1024 + col); const u32x4 gb = *(const u32x4*)(sgb + (size_t)row * 1024 + col);
                    f32x4 r0; f32x4 r1;
                    r0[0] = bflo(ga.x) * __builtin_amdgcn_rcpf(bflo(gb.x)); r0[1] = bfhi(ga.x) * __builtin_amdgcn_rcpf(bfhi(gb.x)); r0[2] = bflo(ga.y) * __builtin_amdgcn_rcpf(bflo(gb.y)); r0[3] = bfhi(ga.y) * __builtin_amdgcn_rcpf(bfhi(gb.y));
                    r1[0] = bflo(ga.z) * __builtin_amdgcn_rcpf(bflo(gb.z)); r1[1] = bfhi(ga.z) * __builtin_amdgcn_rcpf(bfhi(gb.z)); r1[2] = bflo(ga.w) * __builtin_amdgcn_rcpf(bflo(gb.w)); r1[3] = bfhi(ga.w) * __builtin_amdgcn_rcpf(bfhi(gb.w));
                    acc[ai][bj][m][0] = acc[ai][bj][m][0] * r0; acc[ai][bj][m][1] = acc[ai][bj][m][1] * r1; }
            )
            return true;
        }
        EPI_ROWS(
            EPI_COLS8(
                const u32x4 g = *(const u32x4*)(sgb + (size_t)row * 1024 + col);
                f32x4 v0 = a0; f32x4 v1 = a1;
                v0[0] *= bflo(g.x); v0[1] *= bfhi(g.x); v0[2] *= bflo(g.y); v0[3] *= bfhi(g.y);
                v1[0] *= bflo(g.z); v1[1] *= bfhi(g.z); v1[2] *= bflo(g.w); v1[3] *= bfhi(g.w);
                *(u32x4*)(MG + (size_t)row * 1024 + col) = pack8(v0, v1);
            )
        )
        return false;
    }
};
__device__ void phase4(const Params& p) {
    unsigned char* ws = p.ws;
    const bf16_t* sga = (const bf16_t*)(p.out + O_Y); const bf16_t* sgb = sga + (size_t)T_ALL * 1024;
    EpiP4 E{sga, sgb, (bf16_t*)(ws + OFF_QKV)};
    SchedTwoPass SD{T_ALL / 256, 4, 512 / 64, (int)gridDim.x, (int)blockIdx.x};
    gemm_phase<EpiP4, SchedTwoPass>((const bf16_t*)(ws + OFF_OA), (const bf16_t*)(ws + OFF_WAT), 512, SD, E, (const bf16_t*)(ws + OFF_PL), (const bf16_t*)(ws + OFF_WBT));
}

struct EpiP5 {
    const float* xp; const float* xs; float* x1; bf16_t* x1b; float* ssq;
    __device__ __forceinline__ bool operator()(acc_t& acc, int pm, int pn, int wr, int wc, int fr, int fq, int ui) const {
        EPI_ROWS(
            const float* xr = row < T_P ? xp + (size_t)row * DM : xs + (size_t)(row - T_P) * DM;
            float s = 0.f;
            EPI_COLS8(
                const f32x4 v0 = *(const f32x4*)(xr + col) + a0; const f32x4 v1 = *(const f32x4*)(xr + col + 4) + a1;
                *(u32x4*)(x1b + (size_t)row * 1024 + col) = pack8(v0, v1);
                s += ((v0[0] * v0[0] + v0[1] * v0[1]) + (v0[2] * v0[2] + v0[3] * v0[3])) + ((v1[0] * v1[0] + v1[1] * v1[1]) + (v1[2] * v1[2] + v1[3] * v1[3]));
            )
            s += __shfl_xor(s, 16); s += __shfl_xor(s, 32);
            if (fq == 0) ssq[(size_t)row * 16 + pn * 4 + wc] = s;
        )
        return false;
    }
};
__device__ void phase5(const Params& p) {
    unsigned char* ws = p.ws;
    EpiP5 E{p.in[0], p.in[1], p.out + O_Y, (bf16_t*)(ws + OFF_R1), (float*)(ws + OFF_SSQ2)};
    SchedStatic SD{T_ALL / 256, 4, 1024 / 64, (int)gridDim.x, (int)blockIdx.x};
    gemm_phase<EpiP5, SchedStatic>((const bf16_t*)(ws + OFF_QKV), (const bf16_t*)(ws + OFF_WOT), 1024, SD, E);
}

__device__ __forceinline__ float rstd_from16(const float* q) {
    const f32x4 a = *(const f32x4*)q, b = *(const f32x4*)(q + 4), c = *(const f32x4*)(q + 8), d = *(const f32x4*)(q + 12);
    const float t = ((a[0] + a[1]) + (a[2] + a[3])) + ((b[0] + b[1]) + (b[2] + b[3])) + ((c[0] + c[1]) + (c[2] + c[3])) + ((d[0] + d[1]) + (d[2] + d[3]));
    return rsqrtf(t * (1.0f / 1024.0f) + EPS);
}

struct EpiP6 {
    const float* ssq; bf16_t* HM;
    __device__ __forceinline__ bool operator()(acc_t& acc, int pm, int pn, int wr, int wc, int fr, int fq, int ui) const {
        EPI_ROWS(
            const float rs = rstd_from16(ssq + (size_t)row * 16);
            EPI_COLS8(
                f32x4 v0 = a0 * rs; f32x4 v1 = a1 * rs;
                v0[0] = fmaxf(v0[0], 0.f); v0[1] = fmaxf(v0[1], 0.f); v0[2] = fmaxf(v0[2], 0.f); v0[3] = fmaxf(v0[3], 0.f);
                v1[0] = fmaxf(v1[0], 0.f); v1[1] = fmaxf(v1[1], 0.f); v1[2] = fmaxf(v1[2], 0.f); v1[3] = fmaxf(v1[3], 0.f);
                *(u32x4*)(HM + (size_t)row * 4096 + col) = pack8(v0 * v0, v1 * v1);
            )
        )
        return false;
    }
};
__device__ void phase6(const Params& p) {
    unsigned char* ws = p.ws;
    EpiP6 E{(const float*)(ws + OFF_SSQ2), (bf16_t*)(ws + OFF_HMID)};
    SchedStatic SD{T_ALL / 256, 16, 1024 / 64, (int)gridDim.x, (int)blockIdx.x};
    gemm_phase<EpiP6, SchedStatic>((const bf16_t*)(ws + OFF_R1), (const bf16_t*)(ws + OFF_WUT), 1024, SD, E);
}

struct EpiP7 {
    bf16_t* x1b; bf16_t* part; int sk;
    __device__ __forceinline__ bool operator()(acc_t& acc, int pm, int pn, int wr, int wc, int fr, int fq, int ui) const {
        if (!sk || ui == 0) {
            EPI_ROWS(
                EPI_COLS8(
                    u32x4* px = (u32x4*)(x1b + (size_t)row * 1024 + col);
                    const u32x4 xr = *px;
                    f32x4 v0 = a0; f32x4 v1 = a1;
                    v0[0] += bflo(xr.x); v0[1] += bfhi(xr.x); v0[2] += bflo(xr.y); v0[3] += bfhi(xr.y);
                    v1[0] += bflo(xr.z); v1[1] += bfhi(xr.z); v1[2] += bflo(xr.w); v1[3] += bfhi(xr.w);
                    *px = pack8(v0, v1);
                )
            )
        } else {
            EPI_ROWS(
                EPI_COLS8(
                    u32x4 w; w.x = pk_bf16_c(a0[0], a0[1]); w.y = pk_bf16_c(a0[2], a0[3]); w.z = pk_bf16_c(a1[0], a1[1]); w.w = pk_bf16_c(a1[2], a1[3]);
                    *(u32x4*)(part + (size_t)row * 1024 + col) = w;
                )
            )
        }
        return false;
    }
};
__device__ __forceinline__ int sk_per(int G) {
    const int ntK = 4096 / 64, tot = (T_ALL / 256) * 4 * ntK;
    return (tot % G == 0 && ((tot / G) & 3) == 0 && (tot / G) > ntK && (tot / G) <= 2 * ntK && (G & 31) == 0) ? tot / G : 0;
}
__device__ void phase7(const Params& p) {
    unsigned char* ws = p.ws;
    const int G = gridDim.x, ntK = 4096 / 64, per = sk_per(G);
    EpiP7 E{(bf16_t*)(ws + OFF_R1), (bf16_t*)(ws + OFF_PART), per};
    if (per) {
        const int cb = blockIdx.x, xcd = cb & 7, q = cb >> 3;
        SchedStreamK SD{q & 3, ntK, per, xcd * (G >> 5) + (q >> 2)};
        gemm_phase<EpiP7, SchedStreamK>((const bf16_t*)(ws + OFF_HMID), (const bf16_t*)(ws + OFF_WDT), 4096, SD, E);
    } else {
        SchedStatic SD{T_ALL / 256, 4, ntK, G, (int)blockIdx.x};
        gemm_phase<EpiP7, SchedStatic>((const bf16_t*)(ws + OFF_HMID), (const bf16_t*)(ws + OFF_WDT), 4096, SD, E);
    }
}

__device__ void phase8(const Params& p) {
    const int tid = threadIdx.x, wave = tid >> 6, lane = tid & 63;
    const float* gf = p.in[19]; float* y = p.out + O_Y; const bf16_t* part = (const bf16_t*)(p.ws + OFF_PART); const bf16_t* x1b = (const bf16_t*)(p.ws + OFF_R1);
    const int per = sk_per(gridDim.x);
    f32x4 g[4];
#pragma unroll
    for (int i = 0; i < 4; ++i) g[i] = *(const f32x4*)(gf + i * 256 + lane * 4);
#define P8_LOAD(dst, r_) do { _Pragma("unroll") for (int i = 0; i < 4; ++i) { const u32x2 xw = __builtin_nontemporal_load((const u32x2*)(x1b + (size_t)(r_) * 1024 + i * 256 + lane * 4)); \
            dst[i][0] = bflo(xw.x); dst[i][1] = bfhi(xw.x); dst[i][2] = bflo(xw.y); dst[i][3] = bfhi(xw.y); } } while (0)
    int row = blockIdx.x * 8 + wave;
    f32x4 cur[4];
    if (row < T_ALL) P8_LOAD(cur, row);
    while (row < T_ALL) {
        const int nrow = row + gridDim.x * 8;
        f32x4 nxt[4];
        if (nrow < T_ALL) P8_LOAD(nxt, nrow);
        if (per && (((row >> 8) * 64) % per != 0)) {
#pragma unroll
            for (int i = 0; i < 4; ++i) { const u32x2 pw = __builtin_nontemporal_load((const u32x2*)(part + (size_t)row * 1024 + i * 256 + lane * 4));
                cur[i][0] += bflo(pw.x); cur[i][1] += bfhi(pw.x); cur[i][2] += bflo(pw.y); cur[i][3] += bfhi(pw.y); } }
        float ss = 0.f;
#pragma unroll
        for (int i = 0; i < 4; ++i) ss += (cur[i][0] * cur[i][0] + cur[i][1] * cur[i][1]) + (cur[i][2] * cur[i][2] + cur[i][3] * cur[i][3]);
#pragma unroll
        for (int off = 1; off < 64; off <<= 1) ss += __shfl_xor(ss, off);
        const float rs = rsqrtf(ss * (1.0f / 1024.0f) + EPS);
#pragma unroll
        for (int i = 0; i < 4; ++i) __builtin_nontemporal_store(cur[i] * rs * g[i], (f32x4*)(y + (size_t)row * 1024 + i * 256 + lane * 4));
#pragma unroll
        for (int i = 0; i < 4; ++i) cur[i] = nxt[i];
        row = nrow;
    }
#undef P8_LOAD
}

__global__ void __launch_bounds__(NTHR, 2) hybrid_fwd(Params p) {
    cg::grid_group grid = cg::this_grid();
    extern __shared__ __attribute__((aligned(16))) unsigned char smem[];
    volatile LAS unsigned* st = (volatile LAS unsigned*)((LAS unsigned char*)smem + 131072);
    if (threadIdx.x < 4) st[threadIdx.x] = 0u;
    __syncthreads();
    if (p.ws == nullptr) grid.sync();
    XcdBarrier bar = xcd_barrier_post((unsigned*)(p.ws + OFF_BAR), st);
#ifndef ONLY
#define ONLY -1
#endif
#define PH(n) if (ONLY < 0 || ONLY == n)
    PH(0) phase0(p); xcd_barrier(bar);
    PH(1) phase1(p); xcd_barrier(bar);
    PH(2) phase2(p); xcd_barrier(bar);
    PH(3) phase3(p); xcd_barrier(bar);
    PH(3) phase3b(p); xcd_barrier(bar);
    PH(4) phase4(p); xcd_barrier(bar);
    PH(5) phase5(p); xcd_barrier(bar);
    PH(6) phase6(p); xcd_barrier(bar);
    PH(7) phase7(p); xcd_barrier(bar);
    PH(8) phase8(p);
}

extern "C" void kernel_launch(void* const* d_in, const int* in_sizes, int n_in, void* d_out, int out_size, void* d_ws, size_t ws_size, hipStream_t stream) {
    static int grid_blocks = 0;
    if (grid_blocks == 0) {
        if (n_in != 20 || ws_size < WS_END) { fprintf(stderr, "kernel_launch: unexpected n_in %d / ws_size %zu\n", n_in, ws_size); grid_blocks = -1; return; }
        int dev = 0, cus = 0, per_cu = 0;
        hipGetDevice(&dev);
        hipDeviceGetAttribute(&cus, hipDeviceAttributeMultiprocessorCount, dev);
        if (hipFuncSetAttribute((const void*)hybrid_fwd, hipFuncAttributeMaxDynamicSharedMemorySize, LDS_BYTES) != hipSuccess) { fprintf(stderr, "kernel_launch: hipFuncSetAttribute failed\n"); grid_blocks = -1; return; }
        if (hipOccupancyMaxActiveBlocksPerMultiprocessor(&per_cu, (const void*)hybrid_fwd, NTHR, LDS_BYTES) != hipSuccess || per_cu < 1) { fprintf(stderr, "kernel_launch: occupancy query failed (%d)\n", per_cu); per_cu = 1; }
        (void)hipGetLastError();
        grid_blocks = cus;
        fprintf(stderr, "kernel_launch: cus %d per_cu %d grid %d\n", cus, per_cu, grid_blocks);
    }
    if (grid_blocks < 0) return;
    if (hipMemsetAsync((unsigned char*)d_ws + OFF_BAR, 0, XCD_BAR_WORDS * 4, stream) != hipSuccess) { fprintf(stderr, "kernel_launch: memset failed\n"); return; }
    Params p{};
    for (int i = 0; i < 20; ++i) p.in[i] = (const float*)d_in[i];
    p.out = (float*)d_out; p.ws = (unsigned char*)d_ws;
    void* args[] = {&p};
    hipError_t e = hipLaunchCooperativeKernel((const void*)hybrid_fwd, dim3(grid_blocks), dim3(NTHR), args, LDS_BYTES, stream);
    if (e != hipSuccess) fprintf(stderr, "kernel_launch: cooperative launch failed: %s (grid %d)\n", hipGetErrorString(e), grid_blocks);
}
```
